# Optimizing an MI355X kernel written in HIP

```python
import jax
import jax.numpy as jnp
from jax import lax
import numpy as np

D_MODEL = 2048
BATCH = 4
SEQ = 4096
DEPTH = 2

GRID_W = 64
CTX_LEN = 256
HEAD_DIM = 128
ROPE_THETA = 10000.0
EPS = 1e-6
A_HEADS = 8
A_KV_HEADS = 2
WINDOW = 128
WBLOCK = 128
B_HEADS = 8
Q_LORA = 512
KV_LORA = 512
NOPE_DIM = 128
ROPE_DIM = 64
V_DIM = 128
Q_BLOCK = 128
C_GROUPS = 8
C_GROUP_DIM = 128
CHUNK = 128

A_WIDTH = A_HEADS * HEAD_DIM
A_KV_WIDTH = A_KV_HEADS * HEAD_DIM
B_WIDTH = B_HEADS * V_DIM
C_WIDTH = C_GROUPS * C_GROUP_DIM
IN_SPLITS = (A_WIDTH, A_KV_WIDTH, A_KV_WIDTH, A_WIDTH,
             Q_LORA, KV_LORA, ROPE_DIM, B_WIDTH,
             C_WIDTH, C_WIDTH, C_WIDTH,
             D_MODEL, D_MODEL, D_MODEL)
IN_COLS = sum(IN_SPLITS)
IN_OFFSETS = tuple(sum(IN_SPLITS[:i + 1]) for i in range(len(IN_SPLITS) - 1))

kernel_name = 'hybrid_gated_swa_mla_sgu_prefix_dit'


def rms_norm(x, g):
    xf = x.astype(jnp.float32)
    y = xf * lax.rsqrt(jnp.mean(xf * xf, axis=-1, keepdims=True) + EPS)
    return (y * g.astype(jnp.float32)).astype(x.dtype)


def _rope_1d(x, pos):
    half = x.shape[-1] // 2
    inv = ROPE_THETA ** (-jnp.arange(half, dtype=jnp.float32) / half)
    ang = pos[:, None] * inv[None, :]
    cos = jnp.cos(ang)[:, None, :].astype(x.dtype)
    sin = jnp.sin(ang)[:, None, :].astype(x.dtype)
    x1, x2 = x[..., :half], x[..., half:]
    return jnp.concatenate([x1 * cos - x2 * sin, x1 * sin + x2 * cos], axis=-1)


def axial_rope(x, row, col):
    d2 = x.shape[-1] // 2
    return jnp.concatenate([_rope_1d(x[..., :d2], row), _rope_1d(x[..., d2:], col)], axis=-1)


def window_gqa(q, k, v, kc, vc, sink):
    b, n, h, d = q.shape
    kvh = k.shape[2]
    g = h // kvh
    nb = n // WBLOCK
    scale = d ** -0.5
    qb = q.reshape(b, nb, WBLOCK, kvh, g, d)
    pad = ((0, 0), (WBLOCK, WBLOCK), (0, 0), (0, 0))
    kp = jnp.pad(k, pad).reshape(b, nb + 2, WBLOCK, kvh, d)
    vp = jnp.pad(v, pad).reshape(b, nb + 2, WBLOCK, kvh, d)
    kw = jnp.concatenate([kp[:, :-2], kp[:, 1:-1], kp[:, 2:]], axis=2)
    vw = jnp.concatenate([vp[:, :-2], vp[:, 1:-1], vp[:, 2:]], axis=2)
    s_loc = jnp.einsum('bnqkgd,bnjkd->bnkgqj', qb, kw).astype(jnp.float32) * scale
    qi = jnp.arange(WBLOCK)[:, None]
    kj = jnp.arange(3 * WBLOCK)[None, :]
    rel = kj - qi
    band = (rel >= WBLOCK - WINDOW) & (rel <= WBLOCK + WINDOW)
    jpos = jnp.arange(nb)[:, None] * WBLOCK - WBLOCK + jnp.arange(3 * WBLOCK)[None, :]
    valid = band[None] & ((jpos >= 0) & (jpos < n))[:, None, :]
    s_loc = jnp.where(valid[None, :, None, None], s_loc, -1e30)
    s_ctx = jnp.einsum('bnqkgd,bjkd->bnkgqj', qb, kc).astype(jnp.float32) * scale
    s_sink = jnp.broadcast_to(sink.astype(jnp.float32).reshape(kvh, g)[None, None, :, :, None, None],
                              s_loc.shape[:-1] + (1,))
    p = jax.nn.softmax(jnp.concatenate([s_loc, s_ctx, s_sink], axis=-1), axis=-1).astype(v.dtype)
    nw = 3 * WBLOCK
    nc = kc.shape[1]
    o = (jnp.einsum('bnkgqj,bnjkd->bnqkgd', p[..., :nw], vw)
         + jnp.einsum('bnkgqj,bjkd->bnqkgd', p[..., nw:nw + nc], vc))
    return o.reshape(b, n, h * d)


def context_gqa(q, k, v, sink):
    b, l, h, d = q.shape
    kvh = k.shape[2]
    g = h // kvh
    qg = q.reshape(b, l, kvh, g, d)
    s = jnp.einsum('bqkgd,bjkd->bkgqj', qg, k).astype(jnp.float32) * (d ** -0.5)
    s_sink = jnp.broadcast_to(sink.astype(jnp.float32).reshape(kvh, g)[None, :, :, None, None],
                              s.shape[:-1] + (1,))
    p = jax.nn.softmax(jnp.concatenate([s, s_sink], axis=-1), axis=-1)[..., :l].astype(v.dtype)
    return jnp.einsum('bkgqj,bjkd->bqkgd', p, v).reshape(b, l, h * d)


def mla_project(cq, ckv, g_q, g_kv, w_uq, w_ukv):
    b, n, _ = cq.shape
    q = (rms_norm(cq, g_q) @ w_uq).reshape(b, n, B_HEADS, NOPE_DIM + ROPE_DIM)
    kv = (rms_norm(ckv, g_kv) @ w_ukv).reshape(b, n, B_HEADS, NOPE_DIM + V_DIM)
    return q[..., :NOPE_DIM], q[..., NOPE_DIM:], kv[..., :NOPE_DIM], kv[..., NOPE_DIM:]


def mla_dense(qn, qr, kn, kr, v, knc, krc, vc):
    b, n, h, _ = qn.shape
    nb = n // Q_BLOCK
    scale = (NOPE_DIM + ROPE_DIM) ** -0.5

    def block(qs):
        qn_b, qr_b = qs
        s_lat = jnp.einsum('bqhd,bkhd->bhqk', qn_b, kn) + jnp.einsum('bqhd,bkd->bhqk', qr_b, kr)
        s_ctx = jnp.einsum('bqhd,bkhd->bhqk', qn_b, knc) + jnp.einsum('bqhd,bkd->bhqk', qr_b, krc)
        p = jax.nn.softmax(jnp.concatenate([s_lat, s_ctx], axis=-1).astype(jnp.float32) * scale,
                           axis=-1).astype(v.dtype)
        return (jnp.einsum('bhqk,bkhd->bqhd', p[..., :n], v)
                + jnp.einsum('bhqk,bkhd->bqhd', p[..., n:], vc))

    def to_blocks(t):
        return t.reshape(b, nb, Q_BLOCK, h, t.shape[-1]).swapaxes(0, 1)

    o = lax.map(block, (to_blocks(qn), to_blocks(qr)))
    return o.swapaxes(0, 1).reshape(b, n, h * V_DIM)


def mla_context(qn, qr, kn, kr, v):
    b, l, h, _ = qn.shape
    scale = (NOPE_DIM + ROPE_DIM) ** -0.5
    s = jnp.einsum('bqhd,bkhd->bhqk', qn, kn) + jnp.einsum('bqhd,bkd->bhqk', qr, kr)
    p = jax.nn.softmax(s.astype(jnp.float32) * scale, axis=-1).astype(v.dtype)
    return jnp.einsum('bhqk,bkhd->bqhd', p, v).reshape(b, l, h * V_DIM)


def chunk_sgu(u, v, ln_g, ln_b, w_s, b_s):
    b, n, _ = v.shape
    vf = v.astype(jnp.float32)
    mu = jnp.mean(vf, axis=-1, keepdims=True)
    var = jnp.mean(jnp.square(vf - mu), axis=-1, keepdims=True)
    vn = ((vf - mu) * lax.rsqrt(var + EPS) * ln_g.astype(jnp.float32)
          + ln_b.astype(jnp.float32)).astype(v.dtype)
    vb = vn.reshape(b, n // CHUNK, CHUNK, C_GROUPS, C_GROUP_DIM)
    mixed = jnp.einsum('gpq,bcqgd->bcpgd', w_s, vb) + b_s.T[None, None, :, :, None]
    return u * mixed.reshape(b, n, C_WIDTH)


def merge_branches(ya, za, ga, yb, zb, gb, yc, zc, gc, w_pa, w_pb, w_pc, w_out):
    m = (jax.nn.sigmoid(ga) * ((ya * jax.nn.silu(za)) @ w_pa)
         + jax.nn.sigmoid(gb) * ((yb * jax.nn.silu(zb)) @ w_pb)
         + jax.nn.sigmoid(gc) * ((yc * jax.nn.silu(zc)) @ w_pc))
    return m @ w_out


def hybrid_layer(x, xc, c, c_ctx, row, col, ada_w, ada_b, norm_g, w_in, sink_a, mla_gq, mla_gkv,
                 w_uq, w_ukv, sgu_ln_g, sgu_ln_b, sgu_w, sgu_b, w_pa, w_pb, w_pc, w_out, need_ctx_out):
    b, n, _ = x.shape
    lc = xc.shape[1]
    shift, scale, gate = jnp.split((jax.nn.silu(c) @ ada_w + ada_b)[:, None, :], 3, axis=-1)
    shift_c, scale_c, gate_c = jnp.split(jax.nn.silu(c_ctx) @ ada_w + ada_b, 3)
    h = rms_norm(x, norm_g) * (1 + scale) + shift
    hc = rms_norm(xc, norm_g) * (1 + scale_c) + shift_c
    (aq, ak, av, az, bcq, bckv, bkr, bz, cu, cv, cz, g_a, g_b, g_c) = jnp.split(h @ w_in, IN_OFFSETS, axis=-1)
    (aqc, akc, avc, azc, bcqc, bckvc, bkrc, bzc, cuc, cvc, czc, g_ac, g_bc, g_cc) = jnp.split(
        hc @ w_in, IN_OFFSETS, axis=-1)

    q_a = axial_rope(aq.reshape(b, n, A_HEADS, HEAD_DIM), row, col)
    k_a = axial_rope(ak.reshape(b, n, A_KV_HEADS, HEAD_DIM), row, col)
    v_a = av.reshape(b, n, A_KV_HEADS, HEAD_DIM)
    k_ac = akc.reshape(b, lc, A_KV_HEADS, HEAD_DIM)
    v_ac = avc.reshape(b, lc, A_KV_HEADS, HEAD_DIM)
    y_a = window_gqa(q_a, k_a, v_a, k_ac, v_ac, sink_a)

    qn, qr, kn, vb = mla_project(bcq, bckv, mla_gq, mla_gkv, w_uq, w_ukv)
    qr = axial_rope(qr, row, col)
    kr = axial_rope(bkr[:, :, None, :], row, col)[:, :, 0]
    qnc, qrc, knc, vbc = mla_project(bcqc, bckvc, mla_gq, mla_gkv, w_uq, w_ukv)
    y_b = mla_dense(qn, qr, kn, kr, vb, knc, bkrc, vbc)

    y_c = chunk_sgu(cu, cv, sgu_ln_g, sgu_ln_b, sgu_w, sgu_b)

    x_new = x + gate * merge_branches(y_a, az, g_a, y_b, bz, g_b, y_c, cz, g_c, w_pa, w_pb, w_pc, w_out)

    if need_ctx_out:
        y_ac = context_gqa(aqc.reshape(b, lc, A_HEADS, HEAD_DIM), k_ac, v_ac, sink_a)
        y_bc = mla_context(qnc, qrc, knc, bkrc, vbc)
        y_cc = chunk_sgu(cuc, cvc, sgu_ln_g, sgu_ln_b, sgu_w, sgu_b)
        xc_new = xc + gate_c * merge_branches(y_ac, azc, g_ac, y_bc, bzc, g_bc, y_cc, czc, g_cc,
                                              w_pa, w_pb, w_pc, w_out)
    else:
        xc_new = xc
    return x_new, xc_new


def setup_inputs(seed: int = 0) -> dict:
    key = jax.random.key(seed)
    ks = jax.random.split(key, 24)
    f32 = jnp.float32
    L = DEPTH
    D = D_MODEL

    def nrm(k, shape, s):
        return jax.random.normal(k, shape, f32) * s

    return {
        'x': nrm(ks[0], (BATCH, SEQ, D), 1.0),
        'c': nrm(ks[1], (BATCH, D), 1.0),
        'ctx': nrm(ks[2], (BATCH, CTX_LEN, D), 1.0),
        'c_ctx': nrm(ks[3], (D,), 1.0),
        'ada_w': nrm(ks[4], (L, D, 3 * D), 0.5 * D ** -0.5),
        'ada_b': nrm(ks[5], (L, 3 * D), 0.02),
        'norm_g': 1.0 + nrm(ks[6], (L, D), 0.02),
        'w_in': nrm(ks[7], (L, D, IN_COLS), D ** -0.5),
        'sink_a': nrm(ks[8], (L, A_HEADS), 0.5),
        'mla_gq': 1.0 + nrm(ks[9], (L, Q_LORA), 0.02),
        'mla_gkv': 1.0 + nrm(ks[10], (L, KV_LORA), 0.02),
        'w_uq': nrm(ks[11], (L, Q_LORA, B_HEADS * (NOPE_DIM + ROPE_DIM)), Q_LORA ** -0.5),
        'w_ukv': nrm(ks[12], (L, KV_LORA, B_HEADS * (NOPE_DIM + V_DIM)), KV_LORA ** -0.5),
        'sgu_ln_g': 1.0 + nrm(ks[13], (L, C_WIDTH), 0.02),
        'sgu_ln_b': nrm(ks[14], (L, C_WIDTH), 0.02),
        'sgu_w': nrm(ks[15], (L, C_GROUPS, CHUNK, CHUNK), CHUNK ** -0.5),
        'sgu_b': 1.0 + nrm(ks[16], (L, C_GROUPS, CHUNK), 0.1),
        'w_pa': nrm(ks[17], (L, A_WIDTH, D), A_WIDTH ** -0.5),
        'w_pb': nrm(ks[18], (L, B_WIDTH, D), B_WIDTH ** -0.5),
        'w_pc': nrm(ks[19], (L, C_WIDTH, D), C_WIDTH ** -0.5),
        'w_out': nrm(ks[20], (L, D, D), D ** -0.5),
        'final_g': 1.0 + nrm(ks[21], (D,), 0.02),
    }


def reference(x, c, ctx, c_ctx, ada_w, ada_b, norm_g, w_in, sink_a, mla_gq, mla_gkv, w_uq, w_ukv,
              sgu_ln_g, sgu_ln_b, sgu_w, sgu_b, w_pa, w_pb, w_pc, w_out, final_g):
    n = x.shape[1]
    rows = n // GRID_W
    row = jnp.repeat(jnp.arange(rows, dtype=jnp.float32), GRID_W)
    col = jnp.tile(jnp.arange(GRID_W, dtype=jnp.float32), rows)
    xc = ctx
    for l in range(DEPTH):
        x, xc = hybrid_layer(x, xc, c, c_ctx, row, col, ada_w[l], ada_b[l], norm_g[l], w_in[l],
                             sink_a[l], mla_gq[l], mla_gkv[l], w_uq[l], w_ukv[l], sgu_ln_g[l],
                             sgu_ln_b[l], sgu_w[l], sgu_b[l], w_pa[l], w_pb[l], w_pc[l], w_out[l],
                             l < DEPTH - 1)
    return rms_norm(x, final_g)
```

```cpp
#include <hip/hip_runtime.h>
#include <hip/hip_cooperative_groups.h>
#include <cstdio>
namespace cg = cooperative_groups;

#ifndef MK_MULTI
#define MK_MULTI 1
#endif


typedef unsigned short u16;
typedef __attribute__((ext_vector_type(8))) short bf16x8;
typedef __attribute__((ext_vector_type(4))) short s16x4;
typedef __attribute__((ext_vector_type(16))) float f32x16;
typedef __attribute__((ext_vector_type(4))) float f32x4;
typedef __attribute__((ext_vector_type(4))) unsigned u32x4;
typedef __attribute__((ext_vector_type(2))) unsigned u32x2;
typedef u32x4 __attribute__((may_alias)) u32x4_a;
typedef u32x2 __attribute__((may_alias)) u32x2_a;
typedef f32x4 __attribute__((may_alias)) f32x4_a;
typedef bf16x8 __attribute__((may_alias)) bf16x8_a;
typedef s16x4 __attribute__((may_alias)) s16x4_a;

#define DI __device__ __forceinline__

constexpr int T_TOK = 17408, NLAT = 16384, DM = 2048;
constexpr int NIN = 13952;
constexpr int NT_IN = 61;
constexpr int GATE_ROW0 = 7808;
constexpr float EPS = 1e-6f;
constexpr float LOG2E = 1.4426950408889634f;

constexpr int NTHR = 256;
constexpr int LDS_STRIDE = 144;
constexpr int TILE_BYTES = 128 * LDS_STRIDE;
constexpr int STAGE_BYTES = 2 * TILE_BYTES;
constexpr int SMEM_BYTES = 2 * STAGE_BYTES;
constexpr int CST = 132;
constexpr int EXTRA_OFF = 128 * CST * 4;

struct Params {
  const float *x, *c, *ctx, *c_ctx, *ada_w, *ada_b, *norm_g, *w_in, *sink_a, *mla_gq, *mla_gkv, *w_uq, *w_ukv,
      *sgu_ln_g, *sgu_ln_b, *sgu_w, *sgu_b, *w_pa, *w_pb, *w_pc, *w_out, *final_g;
  float* out;
  u16 *WinT, *WuqT, *WukvT, *WpT, *WoutT, *SguW;
  float *mod, *tab32, *tab16;
  u16 *h, *q_a, *k_a, *vTa_lat, *vTa_ctx, *saz, *cq, *ckv, *sbz, *cu, *cvT, *scz, *kr, *q_b, *kn_b, *vTb_lat, *vTb_ctx,
      *ya, *yb, *yc, *m;
  float *ssq_q, *ssq_kv, *cvst, *xres;
};

DI u16 f2bf(float x) { unsigned u = __float_as_uint(x); u += 0x7fffu + ((u >> 16) & 1u); return (u16)(u >> 16); }
DI unsigned pack2(float a, float b) { return (unsigned)f2bf(a) | ((unsigned)f2bf(b) << 16); }
DI float bf_lo(unsigned v) { return __uint_as_float(v << 16); }
DI float bf_hi(unsigned v) { return __uint_as_float(v & 0xffff0000u); }
DI u32x4 ld16(const void* p) { return *(const u32x4_a*)p; }
DI void st16(void* p, u32x4 v) { *(u32x4_a*)p = v; }
DI f32x16 mfma32(bf16x8 a, bf16x8 b, f32x16 c) { return __builtin_amdgcn_mfma_f32_32x32x16_bf16(a, b, c, 0, 0, 0); }
DI float siluf(float v) { return v / (1.f + __expf(-v)); }
DI float sigmf(float v) { return 1.f / (1.f + __expf(-v)); }
DI int otid() { int t = threadIdx.x; asm volatile("" : "+v"(t)); return t; }
DI int crow(int i, int hh) { return (i & 3) + 8 * (i >> 2) + 4 * hh; }
DI void unpack8(u32x4 v, float (&f)[8]) {
  f[0] = bf_lo(v.x); f[1] = bf_hi(v.x); f[2] = bf_lo(v.y); f[3] = bf_hi(v.y);
  f[4] = bf_lo(v.z); f[5] = bf_hi(v.z); f[6] = bf_lo(v.w); f[7] = bf_hi(v.w);
}
DI u32x4 pack8(const float (&f)[8]) {
  u32x4 r; r.x = pack2(f[0], f[1]); r.y = pack2(f[2], f[3]); r.z = pack2(f[4], f[5]); r.w = pack2(f[6], f[7]); return r;
}
DI void ldstg8(const float* stg, int r, int c8, float (&v)[8]) {
  f32x4 a = *(const f32x4_a*)(stg + r * CST + c8), b = *(const f32x4_a*)(stg + r * CST + c8 + 4);
  v[0] = a.x; v[1] = a.y; v[2] = a.z; v[3] = a.w; v[4] = b.x; v[5] = b.y; v[6] = b.z; v[7] = b.w;
}

DI void gemm_kloop(const u16* __restrict__ A, int lda, const u16* __restrict__ B, int ldb, int K,
                   f32x16 (&acc)[2][2], char* smem) {
  const int tid = otid(), lane = tid & 63, w = tid >> 6, wr = w >> 1, wc = w & 1, lr = lane & 31, hh = lane >> 5;
  const int gr = tid >> 3, gc = (tid & 7) * 8;
  const u16* ga = A + (size_t)gr * lda + gc;
  const u16* gb = B + (size_t)gr * ldb + gc;
  const size_t sa32 = (size_t)32 * lda, sb32 = (size_t)32 * ldb;
  u32x4 ra[4], rb[4];
#pragma unroll
  for (int i = 0; i < 4; i++) { ra[i] = ld16(ga + i * sa32); rb[i] = ld16(gb + i * sb32); }
  const int soff = gr * LDS_STRIDE + gc * 2;
#pragma unroll
  for (int i = 0; i < 4; i++) {
    st16(smem + soff + i * 32 * LDS_STRIDE, ra[i]);
    st16(smem + TILE_BYTES + soff + i * 32 * LDS_STRIDE, rb[i]);
  }
  __syncthreads();
  const int nk = K >> 6;
  const int aoff = (wr * 64 + lr) * LDS_STRIDE + hh * 16;
  const int boff = TILE_BYTES + (wc * 64 + lr) * LDS_STRIDE + hh * 16;
  for (int kt = 0; kt < nk; kt++) {
    const char* cur = smem + (kt & 1) * STAGE_BYTES;
    const bool more = (kt + 1 < nk);
    if (more) {
      ga += 64; gb += 64;
#pragma unroll
      for (int i = 0; i < 4; i++) { ra[i] = ld16(ga + i * sa32); rb[i] = ld16(gb + i * sb32); }
    }
#pragma unroll
    for (int s = 0; s < 4; s++) {
      bf16x8 a0 = *(const bf16x8_a*)(cur + aoff + s * 32);
      bf16x8 a1 = *(const bf16x8_a*)(cur + aoff + 32 * LDS_STRIDE + s * 32);
      bf16x8 b0 = *(const bf16x8_a*)(cur + boff + s * 32);
      bf16x8 b1 = *(const bf16x8_a*)(cur + boff + 32 * LDS_STRIDE + s * 32);
      acc[0][0] = mfma32(a0, b0, acc[0][0]);
      acc[0][1] = mfma32(a0, b1, acc[0][1]);
      acc[1][0] = mfma32(a1, b0, acc[1][0]);
      acc[1][1] = mfma32(a1, b1, acc[1][1]);
    }
    if (more) {
      char* nx = smem + ((kt + 1) & 1) * STAGE_BYTES;
#pragma unroll
      for (int i = 0; i < 4; i++) {
        st16(nx + soff + i * 32 * LDS_STRIDE, ra[i]);
        st16(nx + TILE_BYTES + soff + i * 32 * LDS_STRIDE, rb[i]);
      }
    }
    __syncthreads();
  }
}

DI void zero_acc(f32x16 (&acc)[2][2]) {
#pragma unroll
  for (int a = 0; a < 2; a++)
#pragma unroll
    for (int b = 0; b < 2; b++)
#pragma unroll
      for (int i = 0; i < 16; i++) acc[a][b][i] = 0.f;
}

DI void stage_acc(const f32x16 (&acc)[2][2], float* stg) {
  const int tid = otid(), lane = tid & 63, w = tid >> 6, wr = w >> 1, wc = w & 1, lr = lane & 31, hh = lane >> 5;
#pragma unroll
  for (int ta = 0; ta < 2; ta++)
#pragma unroll
    for (int tb = 0; tb < 2; tb++)
#pragma unroll
      for (int i = 0; i < 16; i++) {
        int row = wr * 64 + ta * 32 + crow(i, hh), col = wc * 64 + tb * 32 + lr;
        stg[row * CST + col] = acc[ta][tb][i];
      }
}

template <int ACT>
DI void epi_plain(const float* stg, u16* dst, int ldo, int ncols, const float* rs) {
  const int tid = otid();
#pragma unroll
  for (int j = 0; j < 8; j++) {
    int id = tid + 256 * j, r = id >> 4, c8 = (id & 15) * 8;
    if (c8 < ncols) {
      float v[8]; ldstg8(stg, r, c8, v);
      float sc = rs ? rs[r] : 1.f;
#pragma unroll
      for (int e = 0; e < 8; e++) {
        float t = v[e] * sc;
        if (ACT == 1) t = siluf(t);
        if (ACT == 2) t = sigmf(t);
        v[e] = t;
      }
      st16(dst + (size_t)r * ldo + c8, pack8(v));
    }
  }
}

template <int HALF>
DI void epi_rope(const float* stg, u16* dst, int ldo, int ncols, bool lat, int pos0, const float* tab, int ropemask,
                 const float* rs) {
  const int tid = otid();
#pragma unroll
  for (int j = 0; j < 8; j++) {
    int id = tid + 256 * j, r = id >> 4, c8 = (id & 15) * 8;
    if (c8 < ncols) {
      float v[8]; ldstg8(stg, r, c8, v);
      float sc = rs ? rs[r] : 1.f;
      bool rot = lat;
      if (HALF == 16) rot = rot && ((ropemask >> (c8 >> 6)) & 1);
      if (rot) {
        const int blk = 2 * HALF;
        int ii = c8 & (2 * blk - 1);
        int axis = ii / blk;
        int wi = ii & (blk - 1);
        bool first = wi < HALF;
        int fi = wi & (HALF - 1);
        float pv[8]; ldstg8(stg, r, first ? c8 + HALF : c8 - HALF, pv);
        int pos = pos0 + r;
        int p = axis ? (pos & 63) : (pos >> 6);
        const float* tb = tab + ((size_t)p * HALF + fi) * 2;
#pragma unroll
        for (int e = 0; e < 8; e++) {
          float cs = tb[2 * e], sn = tb[2 * e + 1];
          v[e] = first ? (v[e] * cs - pv[e] * sn) : (pv[e] * sn + v[e] * cs);
        }
      }
#pragma unroll
      for (int e = 0; e < 8; e++) v[e] *= sc;
      st16(dst + (size_t)r * ldo + c8, pack8(v));
    }
  }
}

DI void epi_trans(const float* stg, u16* dstT, size_t ldT, const float* rs) {
  const int tid = otid();
#pragma unroll
  for (int j = 0; j < 8; j++) {
    int id = tid + 256 * j, c = id & 127, r8 = (id >> 7) * 8;
    float v[8];
#pragma unroll
    for (int e = 0; e < 8; e++) v[e] = stg[(r8 + e) * CST + c] * (rs ? rs[r8 + e] : 1.f);
    st16(dstT + (size_t)c * ldT + r8, pack8(v));
  }
}

template <bool WITH_SUM>
DI void epi_rowstat(const float* stg, float* dst, int stride, int off) {
  const int tid = otid(), r = tid >> 1, half = tid & 1;
  float s1 = 0.f, s2 = 0.f;
  for (int i = 0; i < 64; i++) {
    float v = stg[r * CST + half * 64 + ((i + r) & 63)];
    s1 += v; s2 += v * v;
  }
  s1 += __shfl_xor(s1, 1); s2 += __shfl_xor(s2, 1);
  if (half == 0) {
    if (WITH_SUM) { dst[(size_t)r * stride + off] = s1; dst[(size_t)r * stride + off + 1] = s2; }
    else dst[(size_t)r * stride + off] = s2;
  }
}

DI bool patch_tile(int round, int bid, int nb, int MT, int NTl, int& mt, int& nt) {
  const int PN = nb >> 6;
  const int npm = MT >> 3, npn = (NTl + PN - 1) / PN;
  int patch = round * 8 + (bid & 7);
  if (patch >= npm * npn) return false;
  int pmg = patch % npm, png = patch / npm, within = bid >> 3;
  mt = pmg * 8 + (within & 7);
  nt = png * PN + (within >> 3);
  return nt < NTl;
}
DI int patch_rounds(int nb, int MT, int NTl) {
  const int PN = nb >> 6;
  return ((MT >> 3) * ((NTl + PN - 1) / PN) + 7) >> 3;
}

DI void transpose_item(const float* __restrict__ src, int ld_src, int k0, int nsrc0, bool zero, const float* kscale,
                       u16* __restrict__ dst, int K, int ndst0, char* smem) {
  float* tl = (float*)smem;
  const int tid = threadIdx.x;
  const int nn = tid & 63, kk0 = tid >> 6;
#pragma unroll
  for (int i = 0; i < 16; i++) {
    int kk = kk0 + 4 * i;
    float v = zero ? 0.f : src[(size_t)(k0 + kk) * ld_src + nsrc0 + nn];
    if (kscale) v *= kscale[k0 + kk];
    tl[kk * 65 + nn] = v;
  }
  __syncthreads();
  const int n = tid >> 2, ks = (tid & 3) * 16;
  u32x4 o0, o1;
  o0.x = pack2(tl[(ks + 0) * 65 + n], tl[(ks + 1) * 65 + n]);
  o0.y = pack2(tl[(ks + 2) * 65 + n], tl[(ks + 3) * 65 + n]);
  o0.z = pack2(tl[(ks + 4) * 65 + n], tl[(ks + 5) * 65 + n]);
  o0.w = pack2(tl[(ks + 6) * 65 + n], tl[(ks + 7) * 65 + n]);
  o1.x = pack2(tl[(ks + 8) * 65 + n], tl[(ks + 9) * 65 + n]);
  o1.y = pack2(tl[(ks + 10) * 65 + n], tl[(ks + 11) * 65 + n]);
  o1.z = pack2(tl[(ks + 12) * 65 + n], tl[(ks + 13) * 65 + n]);
  o1.w = pack2(tl[(ks + 14) * 65 + n], tl[(ks + 15) * 65 + n]);
  u16* d = dst + (size_t)(ndst0 + n) * K + k0 + ks;
  st16(d, o0); st16(d + 8, o1);
  __syncthreads();
}

DI void ada_item(const Params& P, int it, char* smem) {
  const int tid = threadIdx.x;
  const int l = it / 192, cc = it % 192;
  float* sc = (float*)smem;
  for (int i = tid; i < 5 * 2048; i += 256) {
    int r = i >> 11, k = i & 2047;
    float v = (r < 4) ? P.c[r * 2048 + k] : P.c_ctx[k];
    sc[i] = v / (1.f + expf(-v));
  }
  __syncthreads();
  const int cl = tid & 31, kg = tid >> 5;
  const float* wp = P.ada_w + (size_t)l * 2048 * 6144 + cc * 32 + cl;
  float a0 = 0.f, a1 = 0.f, a2 = 0.f, a3 = 0.f, a4 = 0.f;
#pragma unroll 8
  for (int k = kg * 256; k < kg * 256 + 256; k++) {
    float wv = wp[(size_t)k * 6144];
    a0 += wv * sc[k]; a1 += wv * sc[2048 + k]; a2 += wv * sc[4096 + k]; a3 += wv * sc[6144 + k]; a4 += wv * sc[8192 + k];
  }
  float* red = (float*)(smem + 40960);
  red[(kg * 5 + 0) * 32 + cl] = a0; red[(kg * 5 + 1) * 32 + cl] = a1; red[(kg * 5 + 2) * 32 + cl] = a2;
  red[(kg * 5 + 3) * 32 + cl] = a3; red[(kg * 5 + 4) * 32 + cl] = a4;
  __syncthreads();
  if (tid < 160) {
    int r = tid >> 5, c2 = tid & 31;
    float s = 0.f;
    for (int g = 0; g < 8; g++) s += red[(g * 5 + r) * 32 + c2];
    P.mod[(size_t)(l * 5 + r) * 6144 + cc * 32 + c2] = s + P.ada_b[l * 6144 + cc * 32 + c2];
  }
  __syncthreads();
}

constexpr int W_ADA = 384, W_TAB = 1, W_SGU = 128;
constexpr int W_L_WIN = 218 * 32, W_L_UQ = 24 * 8, W_L_UKV = 32 * 8, W_L_WP = 3 * 32 * 16, W_L_WOUT = 32 * 32;
constexpr int W_L = W_L_WIN + W_L_UQ + W_L_UKV + W_L_WP + W_L_WOUT;
constexpr int W_PRE = W_ADA + W_TAB + W_SGU;

DI void phase_w(const Params& P, int l, int bid, int nb, char* smem) {
  const int tid = threadIdx.x;
  const int pre = (l == 0) ? W_PRE : 0;
  for (int it = bid; it < pre + W_L; it += nb) {
    if (it < pre) {
      if (it < W_ADA) { ada_item(P, it, smem); continue; }
      int i = it - W_ADA;
      if (i < W_TAB) {
        for (int e = tid; e < 64 * 32; e += 256) {
          int pos = e >> 5, fi = e & 31;
          float inv = powf(10000.f, -(float)fi / 32.f);
          float ang = (float)pos * inv;
          P.tab32[e * 2] = cosf(ang); P.tab32[e * 2 + 1] = sinf(ang);
        }
        for (int e = tid; e < 64 * 16; e += 256) {
          int pos = e >> 4, fi = e & 15;
          float inv = powf(10000.f, -(float)fi / 16.f);
          float ang = (float)pos * inv;
          P.tab16[e * 2] = cosf(ang); P.tab16[e * 2 + 1] = sinf(ang);
        }
        continue;
      }
      i -= W_TAB;
      {
        size_t base = (size_t)i * 2048 + tid * 8;
        f32x4 a = *(const f32x4_a*)(P.sgu_w + base), b = *(const f32x4_a*)(P.sgu_w + base + 4);
        u32x4 o; o.x = pack2(a.x, a.y); o.y = pack2(a.z, a.w); o.z = pack2(b.x, b.y); o.w = pack2(b.z, b.w);
        st16(P.SguW + base, o);
      }
      continue;
    }
    int i = it - pre;
    if (i < W_L_WIN) {
      int nbk = i >> 5, kb = i & 31;
      int nd = nbk * 64;
      bool zero = (nd == 7744);
      int ns = nd < 3584 ? nd : (nd < 7680 ? nd + 64 : (nd == 7680 ? 3584 : nd - 64));
      transpose_item(P.w_in + (size_t)l * 2048 * 13888, 13888, kb * 64, ns, zero, nullptr, P.WinT, 2048, nd, smem);
      continue;
    }
    i -= W_L_WIN;
    if (i < W_L_UQ) {
      int nbk = i >> 3, kb = i & 7;
      transpose_item(P.w_uq + (size_t)l * 512 * 1536, 1536, kb * 64, nbk * 64, false, P.mla_gq + l * 512, P.WuqT, 512, nbk * 64, smem);
      continue;
    }
    i -= W_L_UQ;
    if (i < W_L_UKV) {
      int nbk = i >> 3, kb = i & 7;
      transpose_item(P.w_ukv + (size_t)l * 512 * 2048, 2048, kb * 64, nbk * 64, false, P.mla_gkv + l * 512, P.WukvT, 512, nbk * 64, smem);
      continue;
    }
    i -= W_L_UKV;
    if (i < W_L_WP) {
      int br = i / 512, j = i % 512;
      int nbk = j >> 4, kb = j & 15;
      const float* src = (br == 0 ? P.w_pa : (br == 1 ? P.w_pb : P.w_pc)) + (size_t)l * 1024 * 2048;
      transpose_item(src, 2048, kb * 64, nbk * 64, false, nullptr, P.WpT + (size_t)br * 2048 * 1024, 1024, nbk * 64, smem);
      continue;
    }
    i -= W_L_WP;
    {
      int nbk = i >> 5, kb = i & 31;
      transpose_item(P.w_out + (size_t)l * 2048 * 2048, 2048, kb * 64, nbk * 64, false, nullptr, P.WoutT, 2048, nbk * 64, smem);
    }
  }
}

DI void phase_norm(const Params& P, int l, int bid, int nb) {
  const int tid = threadIdx.x, lane = tid & 63, w = tid >> 6;
  for (int t = bid * 4 + w; t < T_TOK; t += nb * 4) {
    const float* src = (l == 0) ? (t < NLAT ? P.x + (size_t)t * DM : P.ctx + (size_t)(t - NLAT) * DM) : P.xres + (size_t)t * DM;
    const int mrow = t < NLAT ? (t >> 12) : 4;
    const float* md = P.mod + (size_t)(l * 5 + mrow) * 6144;
    f32x4 v[8];
    float ss = 0.f;
#pragma unroll
    for (int i = 0; i < 8; i++) {
      v[i] = *(const f32x4_a*)(src + (lane + 64 * i) * 4);
      ss += v[i].x * v[i].x + v[i].y * v[i].y + v[i].z * v[i].z + v[i].w * v[i].w;
    }
#pragma unroll
    for (int o = 32; o >= 1; o >>= 1) ss += __shfl_xor(ss, o);
    const float rinv = rsqrtf(ss * (1.f / 2048.f) + EPS);
#pragma unroll
    for (int i = 0; i < 8; i++) {
      int c = (lane + 64 * i) * 4;
      f32x4 g = *(const f32x4_a*)(P.norm_g + l * 2048 + c);
      f32x4 sh = *(const f32x4_a*)(md + c);
      f32x4 sc = *(const f32x4_a*)(md + 2048 + c);
      float o0 = v[i].x * rinv * g.x * (1.f + sc.x) + sh.x;
      float o1 = v[i].y * rinv * g.y * (1.f + sc.y) + sh.y;
      float o2 = v[i].z * rinv * g.z * (1.f + sc.z) + sh.z;
      float o3 = v[i].w * rinv * g.w * (1.f + sc.w) + sh.w;
      u32x2 o; o.x = pack2(o0, o1); o.y = pack2(o2, o3);
      *(u32x2_a*)(P.h + (size_t)t * DM + c) = o;
    }
  }
}

DI void phase_final(const Params& P, int bid, int nb) {
  const int tid = threadIdx.x, lane = tid & 63, w = tid >> 6;
  for (int t = bid * 4 + w; t < NLAT; t += nb * 4) {
    const float* src = P.xres + (size_t)t * DM;
    f32x4 v[8];
    float ss = 0.f;
#pragma unroll
    for (int i = 0; i < 8; i++) {
      v[i] = *(const f32x4_a*)(src + (lane + 64 * i) * 4);
      ss += v[i].x * v[i].x + v[i].y * v[i].y + v[i].z * v[i].z + v[i].w * v[i].w;
    }
#pragma unroll
    for (int o = 32; o >= 1; o >>= 1) ss += __shfl_xor(ss, o);
    const float rinv = rsqrtf(ss * (1.f / 2048.f) + EPS);
#pragma unroll
    for (int i = 0; i < 8; i++) {
      int c = (lane + 64 * i) * 4;
      f32x4 g = *(const f32x4_a*)(P.final_g + c);
      f32x4 o; o.x = v[i].x * rinv * g.x; o.y = v[i].y * rinv * g.y; o.z = v[i].z * rinv * g.z; o.w = v[i].w * rinv * g.w;
      *(f32x4_a*)(P.out + (size_t)t * DM + c) = o;
    }
  }
}

DI void g1_tile(const Params& P, int l, int mt, int nt, char* smem) {
  f32x16 acc[2][2]; zero_acc(acc);
  gemm_kloop(P.h + (size_t)mt * 128 * DM, DM, P.WinT + (size_t)nt * 128 * DM, DM, DM, acc, smem);
  asm volatile("" : "+s"(mt), "+s"(nt));
  float* stg = (float*)smem;
  stage_acc(acc, stg);
  __syncthreads();
  const int tok0 = mt * 128;
  const bool lat = mt < 128;
  const int b = lat ? (mt >> 5) : ((mt - 128) >> 1);
  const int pos0 = lat ? (mt & 31) * 128 : ((mt - 128) & 1) * 128;
  if (nt < 8) {
    epi_rope<32>(stg, P.q_a + (size_t)tok0 * 1024 + nt * 128, 1024, 128, lat, pos0, P.tab32, 3, nullptr);
  } else if (nt < 10) {
    epi_rope<32>(stg, P.k_a + (size_t)tok0 * 256 + (nt - 8) * 128, 256, 128, lat, pos0, P.tab32, 3, nullptr);
  } else if (nt < 12) {
    int kvh = nt - 10;
    if (lat) epi_trans(stg, P.vTa_lat + ((size_t)(b * 2 + kvh) * 128) * 4096 + pos0, 4096, nullptr);
    else     epi_trans(stg, P.vTa_ctx + ((size_t)(b * 2 + kvh) * 128) * 256 + pos0, 256, nullptr);
  } else if (nt < 20) {
    epi_plain<1>(stg, P.saz + (size_t)tok0 * 1024 + (nt - 12) * 128, 1024, 128, nullptr);
  } else if (nt < 24) {
    epi_plain<0>(stg, P.cq + (size_t)tok0 * 512 + (nt - 20) * 128, 512, 128, nullptr);
    epi_rowstat<false>(stg, P.ssq_q + (size_t)tok0 * 4, 4, nt - 20);
  } else if (nt < 28) {
    epi_plain<0>(stg, P.ckv + (size_t)tok0 * 512 + (nt - 24) * 128, 512, 128, nullptr);
    epi_rowstat<false>(stg, P.ssq_kv + (size_t)tok0 * 4, 4, nt - 24);
  } else if (nt < 36) {
    epi_plain<1>(stg, P.sbz + (size_t)tok0 * 1024 + (nt - 28) * 128, 1024, 128, nullptr);
  } else if (nt < 44) {
    epi_plain<0>(stg, P.cu + (size_t)tok0 * 1024 + (nt - 36) * 128, 1024, 128, nullptr);
  } else if (nt < 52) {
    epi_trans(stg, P.cvT + ((size_t)mt * 1024 + (nt - 44) * 128) * 128, 128, nullptr);
    epi_rowstat<true>(stg, P.cvst + (size_t)tok0 * 16, 16, (nt - 44) * 2);
  } else if (nt < 60) {
    epi_plain<1>(stg, P.scz + (size_t)tok0 * 1024 + (nt - 52) * 128, 1024, 128, nullptr);
  } else {
    epi_rope<16>(stg, P.kr + (size_t)tok0 * 64, 64, 64, lat, pos0, P.tab16, 1, nullptr);
  }
  __syncthreads();
}

DI void phase_g1(const Params& P, int l, int bid, int nb, char* smem) {
  const int rounds = patch_rounds(nb, 136, NT_IN);
  for (int r = 0; r < rounds; r++) {
    int mt, nt;
    if (patch_tile(r, bid, nb, 136, NT_IN, mt, nt)) g1_tile(P, l, mt, nt, smem);
  }
}

DI void g2_tile(const Params& P, int l, int mt, int nt, char* smem) {
  f32x16 acc[2][2]; zero_acc(acc);
  const bool isq = nt < 12;
  const u16* A = (isq ? P.cq : P.ckv) + (size_t)mt * 128 * 512;
  const u16* B = isq ? P.WuqT + (size_t)nt * 128 * 512 : P.WukvT + (size_t)(nt - 12) * 128 * 512;
  gemm_kloop(A, 512, B, 512, 512, acc, smem);
  asm volatile("" : "+s"(mt), "+s"(nt));
  float* stg = (float*)smem;
  float* rs = (float*)(smem + EXTRA_OFF);
  stage_acc(acc, stg);
  const int tid = threadIdx.x;
  const int tok0 = mt * 128;
  if (tid < 128) {
    const float* sp = (isq ? P.ssq_q : P.ssq_kv) + (size_t)(tok0 + tid) * 4;
    float s = sp[0] + sp[1] + sp[2] + sp[3];
    rs[tid] = rsqrtf(s * (1.f / 512.f) + EPS);
  }
  __syncthreads();
  const bool lat = mt < 128;
  const int b = lat ? (mt >> 5) : ((mt - 128) >> 1);
  const int pos0 = lat ? (mt & 31) * 128 : ((mt - 128) & 1) * 128;
  if (isq) {
    int m0 = ((nt * 128) % 192) >= 128 ? 1 : 0;
    int m1 = ((nt * 128 + 64) % 192) >= 128 ? 2 : 0;
    epi_rope<16>(stg, P.q_b + (size_t)tok0 * 1536 + nt * 128, 1536, 128, lat, pos0, P.tab16, m0 | m1, rs);
  } else {
    int j = nt - 12, head = j >> 1;
    if ((j & 1) == 0) {
      epi_plain<0>(stg, P.kn_b + (size_t)tok0 * 1024 + head * 128, 1024, 128, rs);
    } else {
      if (lat) epi_trans(stg, P.vTb_lat + ((size_t)(b * 8 + head) * 128) * 4096 + pos0, 4096, rs);
      else     epi_trans(stg, P.vTb_ctx + ((size_t)(b * 8 + head) * 128) * 256 + pos0, 256, rs);
    }
  }
  __syncthreads();
}

constexpr int VST = 144;
constexpr int SV_OFF = 25600;

struct AttnArgs {
  const u16* Q; int ldq;
  const u16* K1; int ldk1;
  const u16* K2;
  int seg0_row, seg0_n; const u16* seg0_vT; int seg0_ldv;
  int seg1_row, seg1_n; const u16* seg1_vT; int seg1_ldv;
  int qpos0, kpos0; bool mask0;
  bool has_sink; float sink_l2; float cscale;
  const u16* gate; u16* out;
};

template <int DQK>
DI void attn_item(const AttnArgs& a, char* smem) {
  constexpr int NS = DQK / 16;
  constexpr int CPR = DQK / 8;
  constexpr int KCH = CPR / 4;
  constexpr int KST = DQK * 2 + 16;
  const int tid = otid(), lane = tid & 63, w = tid >> 6, lr = lane & 31, hh = lane >> 5;
  char* sK = smem;
  char* sV = smem + SV_OFF;

  bf16x8 qf[NS];
  {
    const u16* qp = a.Q + (size_t)(w * 32 + lr) * a.ldq + hh * 8;
#pragma unroll
    for (int s = 0; s < NS; s++) qf[s] = *(const bf16x8_a*)(qp + s * 16);
  }
  const int nt0 = a.seg0_n >> 6, ntot = nt0 + (a.seg1_n >> 6);
  u32x4 pk[KCH], pv[4];
  auto prefetchK = [&](int tl) {
    int krow;
    if (tl < nt0) krow = a.seg0_row + tl * 64; else krow = a.seg1_row + (tl - nt0) * 64;
#pragma unroll
    for (int i = 0; i < KCH; i++) {
      int id = tid + 256 * i, key = id / CPR, cc = id - key * CPR;
      const u16* src = (cc < 16) ? a.K1 + (size_t)(krow + key) * a.ldk1 + cc * 8
                                 : a.K2 + (size_t)(krow + key) * 64 + (cc - 16) * 8;
      pk[i] = ld16(src);
    }
  };
  auto prefetchV = [&](int tl) {
    const u16* vsrc; int ldv;
    if (tl < nt0) { vsrc = a.seg0_vT + tl * 64; ldv = a.seg0_ldv; }
    else { vsrc = a.seg1_vT + (tl - nt0) * 64; ldv = a.seg1_ldv; }
#pragma unroll
    for (int i = 0; i < 4; i++) {
      int id = tid + 256 * i, d = id >> 3, cc = id & 7;
      pv[i] = ld16(vsrc + (size_t)d * ldv + cc * 8);
    }
  };
  f32x16 O[4];
#pragma unroll
  for (int d = 0; d < 4; d++)
#pragma unroll
    for (int i = 0; i < 16; i++) O[d][i] = 0.f;
  float m = a.has_sink ? a.sink_l2 : -1e30f;
  float l = (a.has_sink && hh == 0) ? 1.f : 0.f;
  const int qp = a.qpos0 + w * 32 + lr;

  prefetchK(0); prefetchV(0);
  for (int tl = 0; tl < ntot; tl++) {
    __syncthreads();
#pragma unroll
    for (int i = 0; i < KCH; i++) {
      int id = tid + 256 * i, key = id / CPR, cc = id - key * CPR;
      st16(sK + key * KST + cc * 16, pk[i]);
    }
#pragma unroll
    for (int i = 0; i < 4; i++) {
      int id = tid + 256 * i, d = id >> 3, cc = id & 7;
      st16(sV + d * VST + cc * 16, pv[i]);
    }
    __syncthreads();
    if (tl + 1 < ntot) prefetchK(tl + 1);

    f32x16 S0, S1;
#pragma unroll
    for (int i = 0; i < 16; i++) { S0[i] = 0.f; S1[i] = 0.f; }
    {
      const char* kp0 = sK + lr * KST + hh * 16;
      const char* kp1 = kp0 + 32 * KST;
#pragma unroll
      for (int s = 0; s < NS; s++) {
        bf16x8 k0 = *(const bf16x8_a*)(kp0 + s * 32);
        bf16x8 k1 = *(const bf16x8_a*)(kp1 + s * 32);
        S0 = mfma32(k0, qf[s], S0);
        S1 = mfma32(k1, qf[s], S1);
      }
    }
    const bool domask = a.mask0 && (tl < nt0);
    const int kbase = a.kpos0 + tl * 64 - qp;
    float mx = -1e30f;
#pragma unroll
    for (int i = 0; i < 16; i++) {
      float t0 = S0[i] * a.cscale, t1 = S1[i] * a.cscale;
      if (domask) {
        int d0 = kbase + crow(i, hh), d1 = d0 + 32;
        if (d0 > 128 || d0 < -128) t0 = -1e30f;
        if (d1 > 128 || d1 < -128) t1 = -1e30f;
      }
      S0[i] = t0; S1[i] = t1;
      mx = fmaxf(mx, fmaxf(t0, t1));
    }
    mx = fmaxf(mx, __shfl_xor(mx, 32));
    const float mnew = fmaxf(m, mx);
    const float alpha = __builtin_amdgcn_exp2f(m - mnew);
    m = mnew;
    float ls = 0.f;
#pragma unroll
    for (int i = 0; i < 16; i++) {
      float p0 = __builtin_amdgcn_exp2f(S0[i] - mnew), p1 = __builtin_amdgcn_exp2f(S1[i] - mnew);
      S0[i] = p0; S1[i] = p1; ls += p0 + p1;
    }
    l = l * alpha + ls;
#pragma unroll
    for (int d = 0; d < 4; d++)
#pragma unroll
      for (int i = 0; i < 16; i++) O[d][i] *= alpha;

    u32x4 pp4[4];
#pragma unroll
    for (int sh = 0; sh < 2; sh++) {
      pp4[sh].x = pack2(S0[8 * sh + 0], S0[8 * sh + 1]); pp4[sh].y = pack2(S0[8 * sh + 2], S0[8 * sh + 3]);
      pp4[sh].z = pack2(S0[8 * sh + 4], S0[8 * sh + 5]); pp4[sh].w = pack2(S0[8 * sh + 6], S0[8 * sh + 7]);
      pp4[2 + sh].x = pack2(S1[8 * sh + 0], S1[8 * sh + 1]); pp4[2 + sh].y = pack2(S1[8 * sh + 2], S1[8 * sh + 3]);
      pp4[2 + sh].z = pack2(S1[8 * sh + 4], S1[8 * sh + 5]); pp4[2 + sh].w = pack2(S1[8 * sh + 6], S1[8 * sh + 7]);
    }
    if (tl + 1 < ntot) prefetchV(tl + 1);
#pragma unroll
    for (int kt2 = 0; kt2 < 2; kt2++) {
#pragma unroll
      for (int sh = 0; sh < 2; sh++) {
        u32x4 pp = pp4[kt2 * 2 + sh];
        bf16x8 pf = __builtin_bit_cast(bf16x8, pp);
        const char* vp = sV + lr * VST + (kt2 * 32 + sh * 16 + 4 * hh) * 2;
#pragma unroll
        for (int dt = 0; dt < 4; dt++) {
          s16x4 lo = *(const s16x4_a*)(vp + dt * 32 * VST);
          s16x4 hi = *(const s16x4_a*)(vp + dt * 32 * VST + 16);
          bf16x8 vf = __builtin_shufflevector(lo, hi, 0, 1, 2, 3, 4, 5, 6, 7);
          O[dt] = mfma32(vf, pf, O[dt]);
        }
      }
    }
  }
  const float lt = l + __shfl_xor(l, 32);
  const float linv = 1.f / lt;
  const size_t ro = (size_t)(w * 32 + lr) * 1024;
#pragma unroll
  for (int dt = 0; dt < 4; dt++)
#pragma unroll
    for (int g4 = 0; g4 < 4; g4++) {
      int d = dt * 32 + 8 * g4 + 4 * hh;
      u32x2 gv = *(const u32x2_a*)(a.gate + ro + d);
      float o0 = O[dt][4 * g4 + 0] * linv * bf_lo(gv.x);
      float o1 = O[dt][4 * g4 + 1] * linv * bf_hi(gv.x);
      float o2 = O[dt][4 * g4 + 2] * linv * bf_lo(gv.y);
      float o3 = O[dt][4 * g4 + 3] * linv * bf_hi(gv.y);
      u32x2 ov; ov.x = pack2(o0, o1); ov.y = pack2(o2, o3);
      *(u32x2_a*)(a.out + ro + d) = ov;
    }
  __syncthreads();
}

DI void attnA_any(const Params& P, int l, int it, char* smem) {
  const bool isl = it < 1024;
  const int ia = isl ? it : it - 1024;
  const int hq = ia & 7, kvh = hq >> 2;
  const int qb = isl ? ((ia >> 3) & 31) : ((ia >> 3) & 1);
  const int b = isl ? (ia >> 8) : (ia >> 4);
  AttnArgs a;
  const size_t tq = isl ? ((size_t)b * 4096 + qb * 128) : ((size_t)NLAT + b * 256 + qb * 128);
  a.Q = P.q_a + tq * 1024 + hq * 128; a.ldq = 1024;
  a.K1 = P.k_a + kvh * 128; a.ldk1 = 256; a.K2 = P.k_a;
  int ks = qb * 128 - 128; if (ks < 0) ks = 0;
  int ke = qb * 128 + 256; if (ke > 4096) ke = 4096;
  const u16* vctx = P.vTa_ctx + ((size_t)(b * 2 + kvh) * 128) * 256;
  if (isl) {
    a.seg0_row = b * 4096 + ks; a.seg0_n = ke - ks;
    a.seg0_vT = P.vTa_lat + ((size_t)(b * 2 + kvh) * 128) * 4096 + ks; a.seg0_ldv = 4096;
    a.seg1_row = NLAT + b * 256; a.seg1_n = 256; a.seg1_vT = vctx; a.seg1_ldv = 256;
    a.qpos0 = qb * 128; a.kpos0 = ks; a.mask0 = true;
  } else {
    a.seg0_row = NLAT + b * 256; a.seg0_n = 256; a.seg0_vT = vctx; a.seg0_ldv = 256;
    a.seg1_row = 0; a.seg1_n = 0; a.seg1_vT = vctx; a.seg1_ldv = 256;
    a.qpos0 = 0; a.kpos0 = 0; a.mask0 = false;
  }
  a.has_sink = true; a.sink_l2 = P.sink_a[l * 8 + hq] * LOG2E;
  a.cscale = 0.08838834764831845f * LOG2E;
  a.gate = P.saz + tq * 1024 + hq * 128; a.out = P.ya + tq * 1024 + hq * 128;
  attn_item<128>(a, smem);
}
DI void attnB_any(const Params& P, int it, char* smem) {
  const bool isl = it < 1024;
  const int ia = isl ? it : it - 1024;
  const int hq = ia & 7;
  const int qb = isl ? ((ia >> 3) & 31) : ((ia >> 3) & 1);
  const int b = isl ? (ia >> 8) : (ia >> 4);
  AttnArgs a;
  const size_t tq = isl ? ((size_t)b * 4096 + qb * 128) : ((size_t)NLAT + b * 256 + qb * 128);
  a.Q = P.q_b + tq * 1536 + hq * 192; a.ldq = 1536;
  a.K1 = P.kn_b + hq * 128; a.ldk1 = 1024; a.K2 = P.kr;
  const u16* vctx = P.vTb_ctx + ((size_t)(b * 8 + hq) * 128) * 256;
  if (isl) {
    a.seg0_row = b * 4096; a.seg0_n = 4096;
    a.seg0_vT = P.vTb_lat + ((size_t)(b * 8 + hq) * 128) * 4096; a.seg0_ldv = 4096;
    a.seg1_row = NLAT + b * 256; a.seg1_n = 256; a.seg1_vT = vctx; a.seg1_ldv = 256;
  } else {
    a.seg0_row = NLAT + b * 256; a.seg0_n = 256; a.seg0_vT = vctx; a.seg0_ldv = 256;
    a.seg1_row = 0; a.seg1_n = 0; a.seg1_vT = vctx; a.seg1_ldv = 256;
  }
  a.qpos0 = 0; a.kpos0 = 0; a.mask0 = false;
  a.has_sink = false; a.sink_l2 = 0.f;
  a.cscale = 0.07216878364870322f * LOG2E;
  a.gate = P.sbz + tq * 1024 + hq * 128; a.out = P.yb + tq * 1024 + hq * 128;
  attn_item<192>(a, smem);
}

constexpr int SGU_ST = 272;
DI void sgu_item(const Params& P, int l, int ch, int g, char* smem) {
  const int tid = threadIdx.x, lane = tid & 63, w = tid >> 6, wr = w >> 1, wc = w & 1, lr = lane & 31, hh = lane >> 5;
  float* st = (float*)(smem + 2 * 128 * SGU_ST);
  if (tid < 128) {
    const float* sp = P.cvst + (size_t)(ch * 128 + tid) * 16;
    float s1 = 0.f, s2 = 0.f;
#pragma unroll
    for (int j = 0; j < 8; j++) { s1 += sp[2 * j]; s2 += sp[2 * j + 1]; }
    float mu = s1 * (1.f / 1024.f);
    float var = s2 * (1.f / 1024.f) - mu * mu;
    st[tid * 2] = mu; st[tid * 2 + 1] = rsqrtf(fmaxf(var, 0.f) + EPS);
  }
  __syncthreads();
  char* sA = smem; char* sB = smem + 128 * SGU_ST;
  const u16* Ag = P.SguW + (size_t)(l * 8 + g) * 128 * 128;
  const u16* Bg = P.cvT + ((size_t)ch * 1024 + g * 128) * 128;
#pragma unroll
  for (int i = 0; i < 8; i++) {
    int id = tid + 256 * i, r = id >> 4, cc = id & 15;
    st16(sA + r * SGU_ST + cc * 16, ld16(Ag + r * 128 + cc * 8));
    float v[8]; unpack8(ld16(Bg + r * 128 + cc * 8), v);
    float gam = P.sgu_ln_g[l * 1024 + g * 128 + r], bet = P.sgu_ln_b[l * 1024 + g * 128 + r];
#pragma unroll
    for (int e = 0; e < 8; e++) {
      int q = cc * 8 + e;
      v[e] = (v[e] - st[2 * q]) * st[2 * q + 1] * gam + bet;
    }
    st16(sB + r * SGU_ST + cc * 16, pack8(v));
  }
  __syncthreads();
  f32x16 acc[2][2]; zero_acc(acc);
  {
    const char* pa = sA + (wr * 64 + lr) * SGU_ST + hh * 16;
    const char* pb = sB + (wc * 64 + lr) * SGU_ST + hh * 16;
#pragma unroll
    for (int s = 0; s < 8; s++) {
      bf16x8 a0 = *(const bf16x8_a*)(pa + s * 32);
      bf16x8 a1 = *(const bf16x8_a*)(pa + 32 * SGU_ST + s * 32);
      bf16x8 b0 = *(const bf16x8_a*)(pb + s * 32);
      bf16x8 b1 = *(const bf16x8_a*)(pb + 32 * SGU_ST + s * 32);
      acc[0][0] = mfma32(a0, b0, acc[0][0]);
      acc[0][1] = mfma32(a0, b1, acc[0][1]);
      acc[1][0] = mfma32(a1, b0, acc[1][0]);
      acc[1][1] = mfma32(a1, b1, acc[1][1]);
    }
  }
  __syncthreads();
  float* stg = (float*)smem;
  stage_acc(acc, stg);
  __syncthreads();
#pragma unroll
  for (int j = 0; j < 8; j++) {
    int id = tid + 256 * j, r = id >> 4, c8 = (id & 15) * 8;
    float v[8]; ldstg8(stg, r, c8, v);
    const size_t off = (size_t)(ch * 128 + r) * 1024 + g * 128 + c8;
    float u[8], z[8];
    unpack8(ld16(P.cu + off), u); unpack8(ld16(P.scz + off), z);
    float bs = P.sgu_b[(l * 8 + g) * 128 + r];
#pragma unroll
    for (int e = 0; e < 8; e++) v[e] = u[e] * (v[e] + bs) * z[e];
    st16(P.yc + off, pack8(v));
  }
  __syncthreads();
}

DI void phase_g2(const Params& P, int l, int bid, int nb, char* smem) {
  const int na = (l == 0) ? 1088 : 1024;
  for (int it = bid; it < na; it += nb) attnA_any(P, l, it, smem);
  const int rounds = patch_rounds(nb, 136, 28);
  for (int r = 0; r < rounds; r++) {
    int mt, nt;
    if (patch_tile(r, bid, nb, 136, 28, mt, nt)) g2_tile(P, l, mt, nt, smem);
  }
  const int nch = (l == 0) ? 136 : 128;
  for (int it = bid; it < nch * 8; it += nb) sgu_item(P, l, it >> 3, it & 7, smem);
}

DI void phase_attb(const Params& P, int l, int bid, int nb, char* smem) {
  const int na = (l == 0) ? 1088 : 1024;
  for (int it = bid; it < na; it += nb) attnB_any(P, it, smem);
}

DI void g3_tile(const Params& P, int l, int mt, int nt, char* smem) {
  f32x16 tot[2][2]; zero_acc(tot);
  const int tok0 = mt * 128;
#pragma unroll 1
  for (int br = 0; br < 3; br++) {
    f32x16 acc[2][2]; zero_acc(acc);
    gemm_kloop(P.h + (size_t)tok0 * DM, DM, P.WinT + ((size_t)GATE_ROW0 + br * 2048 + (size_t)nt * 128) * DM, DM, DM, acc, smem);
    unsigned gp[2][2][8];
#pragma unroll
    for (int a = 0; a < 2; a++)
#pragma unroll
      for (int b = 0; b < 2; b++)
#pragma unroll
        for (int i = 0; i < 8; i++) gp[a][b][i] = pack2(sigmf(acc[a][b][2 * i]), sigmf(acc[a][b][2 * i + 1]));
    zero_acc(acc);
    const u16* A = (br == 0 ? P.ya : (br == 1 ? P.yb : P.yc)) + (size_t)tok0 * 1024;
    gemm_kloop(A, 1024, P.WpT + ((size_t)br * 2048 + (size_t)nt * 128) * 1024, 1024, 1024, acc, smem);
#pragma unroll
    for (int a = 0; a < 2; a++)
#pragma unroll
      for (int b = 0; b < 2; b++)
#pragma unroll
        for (int i = 0; i < 8; i++) {
          tot[a][b][2 * i] += bf_lo(gp[a][b][i]) * acc[a][b][2 * i];
          tot[a][b][2 * i + 1] += bf_hi(gp[a][b][i]) * acc[a][b][2 * i + 1];
        }
  }
  asm volatile("" : "+s"(mt), "+s"(nt));
  float* stg = (float*)smem;
  stage_acc(tot, stg);
  __syncthreads();
  epi_plain<0>(stg, P.m + (size_t)mt * 128 * DM + nt * 128, DM, 128, nullptr);
  __syncthreads();
}
DI void phase_g3(const Params& P, int l, int bid, int nb, char* smem) {
  const int MT = (l == 0) ? 136 : 128;
  const int rounds = patch_rounds(nb, MT, 16);
  for (int r = 0; r < rounds; r++) {
    int mt, nt;
    if (patch_tile(r, bid, nb, MT, 16, mt, nt)) g3_tile(P, l, mt, nt, smem);
  }
}

DI void g4_tile(const Params& P, int l, int mt, int nt, char* smem) {
  const int tid = threadIdx.x;
  f32x16 acc[2][2]; zero_acc(acc);
  gemm_kloop(P.m + (size_t)mt * 128 * DM, DM, P.WoutT + (size_t)nt * 128 * DM, DM, DM, acc, smem);
  asm volatile("" : "+s"(mt), "+s"(nt));
  float* stg = (float*)smem;
  stage_acc(acc, stg);
  __syncthreads();
  const int tok0 = mt * 128;
  const bool lat = mt < 128;
  const int mrow = lat ? (mt >> 5) : 4;
  const float* gp = P.mod + (size_t)(l * 5 + mrow) * 6144 + 4096 + nt * 128;
#pragma unroll
  for (int j = 0; j < 8; j++) {
    int id = tid + 256 * j, r = id >> 4, c8 = (id & 15) * 8;
    float v[8]; ldstg8(stg, r, c8, v);
    const int tok = tok0 + r;
    const float* xin = (l == 0) ? (lat ? P.x + (size_t)tok * DM : P.ctx + (size_t)(tok - NLAT) * DM) : P.xres + (size_t)tok * DM;
    xin += nt * 128 + c8;
    f32x4 x0 = *(const f32x4_a*)(xin), x1 = *(const f32x4_a*)(xin + 4);
    f32x4 g0 = *(const f32x4_a*)(gp + c8), g1 = *(const f32x4_a*)(gp + c8 + 4);
    f32x4 o0, o1;
    o0.x = x0.x + g0.x * v[0]; o0.y = x0.y + g0.y * v[1]; o0.z = x0.z + g0.z * v[2]; o0.w = x0.w + g0.w * v[3];
    o1.x = x1.x + g1.x * v[4]; o1.y = x1.y + g1.y * v[5]; o1.z = x1.z + g1.z * v[6]; o1.w = x1.w + g1.w * v[7];
    float* xo = P.xres + (size_t)tok * DM + nt * 128 + c8;
    *(f32x4_a*)(xo) = o0; *(f32x4_a*)(xo + 4) = o1;
  }
  __syncthreads();
}
DI void phase_g4(const Params& P, int l, int bid, int nb, char* smem) {
  const int MT = (l == 0) ? 136 : 128;
  const int rounds = patch_rounds(nb, MT, 16);
  for (int r = 0; r < rounds; r++) {
    int mt, nt;
    if (patch_tile(r, bid, nb, MT, 16, mt, nt)) g4_tile(P, l, mt, nt, smem);
  }
}

DI void run_phase(const Params& P, int ph, int bid, int nb, char* smem) {
  if (ph == 0) { phase_w(P, 0, bid, nb, smem); return; }
  if (ph == 13) { phase_final(P, bid, nb); return; }
  const int l = (ph - 1) / 6, s = (ph - 1) % 6;
  switch (s) {
    case 0: phase_norm(P, l, bid, nb); if (l == 1) phase_w(P, 1, bid, nb, smem); break;
    case 1: phase_g1(P, l, bid, nb, smem); break;
    case 2: phase_g2(P, l, bid, nb, smem); break;
    case 3: phase_attb(P, l, bid, nb, smem); break;
    case 4: phase_g3(P, l, bid, nb, smem); break;
    default: phase_g4(P, l, bid, nb, smem); break;
  }
}

extern __shared__ __attribute__((aligned(16))) char dyn_smem[];

#if MK_MULTI
__global__ void __launch_bounds__(NTHR, 2) k_phase(Params P, int ph) {
  run_phase(P, ph, blockIdx.x, gridDim.x, dyn_smem);
}
#endif

#if !MK_MULTI
__global__ void __launch_bounds__(NTHR, 2) k_mega(Params P) {
  cg::grid_group grid = cg::this_grid();
  const int bid = blockIdx.x, nb = gridDim.x;
  phase_w(P, 0, bid, nb, dyn_smem); grid.sync();
#pragma unroll 1
  for (int l = 0; l < 2; l++) {
    phase_norm(P, l, bid, nb);
    if (l == 1) phase_w(P, 1, bid, nb, dyn_smem);
    grid.sync();
    phase_g1(P, l, bid, nb, dyn_smem); grid.sync();
    phase_g2(P, l, bid, nb, dyn_smem); grid.sync();
    phase_attb(P, l, bid, nb, dyn_smem); grid.sync();
    phase_g3(P, l, bid, nb, dyn_smem); grid.sync();
    phase_g4(P, l, bid, nb, dyn_smem); grid.sync();
  }
  phase_final(P, bid, nb);
}
#endif

__global__ void k_fill(float* o, int n, float v) { int i = blockIdx.x * 256 + threadIdx.x; if (i < n) o[i] = v; }
extern "C" void kernel_launch(void* const* d_in, const int* in_sizes, int n_in, void* d_out, int out_size, void* d_ws,
                              size_t ws_size, hipStream_t stream) {
  static int grid_blocks = 0;
  if (!grid_blocks) {
    int dev = 0, cus = 0, per_cu = 0;
    hipGetDevice(&dev);
    hipDeviceGetAttribute(&cus, hipDeviceAttributeMultiprocessorCount, dev);
#if MK_MULTI
    const void* kfn = (const void*)k_phase;
#else
    const void* kfn = (const void*)k_mega;
#endif
    hipFuncSetAttribute(kfn, hipFuncAttributeMaxDynamicSharedMemorySize, SMEM_BYTES);
    hipOccupancyMaxActiveBlocksPerMultiprocessor(&per_cu, kfn, NTHR, SMEM_BYTES);
    if (per_cu < 1) per_cu = 1;
    if (per_cu > 2) per_cu = 2;
    grid_blocks = cus * per_cu;
    grid_blocks &= ~63;
    if (grid_blocks < 64) grid_blocks = 64;
    (void)hipGetLastError();
  }
  Params P{};
  const float** ins = (const float**)&P;
  for (int i = 0; i < 22; i++) ins[i] = (const float*)d_in[i];
  P.out = (float*)d_out;
  char* wp = (char*)d_ws;
  auto alloc = [&](size_t bytes) { char* r = wp; wp += (bytes + 255) & ~(size_t)255; return r; };
  const size_t T = T_TOK;
  P.WinT = (u16*)alloc((size_t)NIN * 2048 * 2);
  P.WuqT = (u16*)alloc((size_t)1536 * 512 * 2);
  P.WukvT = (u16*)alloc((size_t)2048 * 512 * 2);
  P.WpT = (u16*)alloc((size_t)3 * 2048 * 1024 * 2);
  P.WoutT = (u16*)alloc((size_t)2048 * 2048 * 2);
  P.SguW = (u16*)alloc((size_t)2 * 8 * 128 * 128 * 2);
  P.mod = (float*)alloc((size_t)2 * 5 * 6144 * 4);
  P.tab32 = (float*)alloc(64 * 32 * 2 * 4);
  P.tab16 = (float*)alloc(64 * 16 * 2 * 4);
  P.h = (u16*)alloc(T * 2048 * 2);
  P.q_a = (u16*)alloc(T * 1024 * 2);
  P.k_a = (u16*)alloc(T * 256 * 2);
  P.vTa_lat = (u16*)alloc((size_t)4 * 2 * 128 * 4096 * 2);
  P.vTa_ctx = (u16*)alloc((size_t)4 * 2 * 128 * 256 * 2);
  P.saz = (u16*)alloc(T * 1024 * 2);
  P.cq = (u16*)alloc(T * 512 * 2);
  P.ckv = (u16*)alloc(T * 512 * 2);
  P.sbz = (u16*)alloc(T * 1024 * 2);
  P.cu = (u16*)alloc(T * 1024 * 2);
  P.cvT = (u16*)alloc(T * 1024 * 2);
  P.scz = (u16*)alloc(T * 1024 * 2);
  P.kr = (u16*)alloc(T * 64 * 2);
  P.q_b = (u16*)alloc(T * 1536 * 2);
  P.kn_b = (u16*)alloc(T * 1024 * 2);
  P.m = P.q_b;
  P.vTb_lat = (u16*)alloc((size_t)4 * 8 * 128 * 4096 * 2);
  P.vTb_ctx = (u16*)alloc((size_t)4 * 8 * 128 * 256 * 2);
  P.ya = P.saz; P.yb = P.sbz; P.yc = P.scz;
  P.ssq_q = (float*)alloc(T * 4 * 4);
  P.ssq_kv = (float*)alloc(T * 4 * 4);
  P.cvst = (float*)alloc(T * 16 * 4);
  P.xres = (float*)alloc(T * 2048 * 4);
  if ((size_t)(wp - (char*)d_ws) > ws_size) {
    fprintf(stderr, "workspace too small\n");
    hipLaunchKernelGGL(k_fill, dim3((out_size + 255) / 256), dim3(256), 0, stream, (float*)d_out, out_size, 7777.f);
    return;
  }
#if MK_MULTI
  for (int ph = 0; ph < 14; ph++) hipLaunchKernelGGL(k_phase, dim3(grid_blocks), dim3(NTHR), SMEM_BYTES, stream, P, ph);
#else
  void* args[] = {&P};
  hipError_t e = hipLaunchCooperativeKernel((const void*)k_mega, dim3(grid_blocks), dim3(NTHR), args, SMEM_BYTES, stream);
  if (e != hipSuccess) fprintf(stderr, "cooperative launch failed: %s (grid %d)\n", hipGetErrorString(e), grid_blocks);
#endif
}
```

```cpp
#include <hip/hip_runtime.h>
#include <hip/hip_cooperative_groups.h>
#include <cstdio>
namespace cg = cooperative_groups;

#ifndef MK_MULTI
#define MK_MULTI 0
#endif
#ifndef MK_DUP
#define MK_DUP 0
#endif

typedef unsigned short u16;
typedef __attribute__((ext_vector_type(8))) short bf16x8;
typedef __attribute__((ext_vector_type(4))) short s16x4;
typedef __attribute__((ext_vector_type(16))) float f32x16;
typedef __attribute__((ext_vector_type(4))) float f32x4;
typedef __attribute__((ext_vector_type(4))) unsigned u32x4;
typedef __attribute__((ext_vector_type(2))) unsigned u32x2;
typedef u32x4 __attribute__((may_alias)) u32x4_a;
typedef u32x2 __attribute__((may_alias)) u32x2_a;
typedef f32x4 __attribute__((may_alias)) f32x4_a;
typedef bf16x8 __attribute__((may_alias)) bf16x8_a;
typedef s16x4 __attribute__((may_alias)) s16x4_a;

#define DI __device__ __forceinline__

constexpr int T_TOK = 17408, NLAT = 16384, DM = 2048;
constexpr int NIN = 14080;
constexpr float EPS = 1e-6f;
constexpr float LOG2E = 1.4426950408889634f;

constexpr int NTHR = 512;
constexpr int CST = 132;
constexpr int HALF_SMEM = 70656;
constexpr int SMEM_BYTES = 2 * HALF_SMEM;

struct Params {
  const float *x, *c, *ctx, *c_ctx, *ada_w, *ada_b, *norm_g, *w_in, *sink_a, *mla_gq, *mla_gkv, *w_uq, *w_ukv,
      *sgu_ln_g, *sgu_ln_b, *sgu_w, *sgu_b, *w_pa, *w_pb, *w_pc, *w_out, *final_g;
  float* out;
  char* ws;
  DI u16* WinT() const { return (u16*)(ws + 0ull); }
  DI u16* WuqT() const { return (u16*)(ws + 57671680ull); }
  DI u16* WukvT() const { return (u16*)(ws + 59244544ull); }
  DI u16* WpT() const { return (u16*)(ws + 61341696ull); }
  DI u16* WoutT() const { return (u16*)(ws + 73924608ull); }
  DI u16* SguW() const { return (u16*)(ws + 82313216ull); }
  DI u16* h() const { return (u16*)(ws + 83107840ull); }
  DI u16* q_a() const { return (u16*)(ws + 738795520ull); }
  DI u16* k_a() const { return (u16*)(ws + 510926848ull); }
  DI u16* vTa_lat() const { return (u16*)(ws + 519839744ull); }
  DI u16* vTa_ctx() const { return (u16*)(ws + 528228352ull); }
  DI u16* saz() const { return (u16*)(ws + 154411008ull); }
  DI u16* cq() const { return (u16*)(ws + 261365760ull); }
  DI u16* ckv() const { return (u16*)(ws + 279191552ull); }
  DI u16* sbz() const { return (u16*)(ws + 190062592ull); }
  DI u16* cu() const { return (u16*)(ws + 528752640ull); }
  DI u16* cvT() const { return (u16*)(ws + 564404224ull); }
  DI u16* scz() const { return (u16*)(ws + 225714176ull); }
  DI u16* sg() const { return (u16*)(ws + 297017344ull); }
  DI u16* kr() const { return (u16*)(ws + 600055808ull); }
  DI u16* q_b() const { return (u16*)(ws + 614014976ull); }
  DI u16* kn_b() const { return (u16*)(ws + 667492352ull); }
  DI u16* vTb_lat() const { return (u16*)(ws + 703143936ull); }
  DI u16* vTb_ctx() const { return (u16*)(ws + 736698368ull); }
  DI u16* ya() const { return (u16*)(ws + 154411008ull); }
  DI u16* yb() const { return (u16*)(ws + 190062592ull); }
  DI u16* yc() const { return (u16*)(ws + 225714176ull); }
  DI u16* m() const { return (u16*)(ws + 614014976ull); }
  DI float* mod() const { return (float*)(ws + 82837504ull); }
  DI float* tab32() const { return (float*)(ws + 83083264ull); }
  DI float* tab16() const { return (float*)(ws + 83099648ull); }
  DI float* ssq_q() const { return (float*)(ws + 602284032ull); }
  DI float* ssq_kv() const { return (float*)(ws + 602841088ull); }
  DI float* cvst() const { return (float*)(ws + 603398144ull); }
  DI float* xres() const { return (float*)(ws + 605626368ull); }
  DI float* gscr() const { return (float*)(ws + 685318144ull); }
};
constexpr size_t WS_BAR = 774447104ull;
constexpr size_t WS_TOTAL = 774451200ull;

DI u16 f2bf(float x) { unsigned u = __float_as_uint(x); u += 0x7fffu + ((u >> 16) & 1u); return (u16)(u >> 16); }
typedef __attribute__((ext_vector_type(2))) float f32x2_t;
typedef __attribute__((ext_vector_type(2))) __bf16 bf16x2_t;
DI unsigned pack2(float a, float b) { f32x2_t v = {a, b}; return __builtin_bit_cast(unsigned, __builtin_convertvector(v, bf16x2_t)); }
DI float bf_lo(unsigned v) { return __uint_as_float(v << 16); }
DI float bf_hi(unsigned v) { return __uint_as_float(v & 0xffff0000u); }
DI u32x4 ld16(const void* p) { return *(const u32x4_a*)p; }
DI void st16(void* p, u32x4 v) { *(u32x4_a*)p = v; }
DI f32x16 mfma32(bf16x8 a, bf16x8 b, f32x16 c) { return __builtin_amdgcn_mfma_f32_32x32x16_bf16(a, b, c, 0, 0, 0); }
DI float siluf(float v) { return v * __builtin_amdgcn_rcpf(1.f + __expf(-v)); }
DI float sigmf(float v) { return __builtin_amdgcn_rcpf(1.f + __expf(-v)); }
DI int otid() { int t = threadIdx.x; asm volatile("" : "+v"(t)); return t; }
DI float shx(float v, int lane, int o) { return __int_as_float(__builtin_amdgcn_ds_bpermute((lane ^ o) << 2, __float_as_int(v))); }
DI int vperm(int t) { return (t & ~15) | (t & 3) | (((t >> 2) & 1) << 3) | (((t >> 3) & 1) << 2); }
DI float max3f(float a, float b, float c) { float r; asm("v_max3_f32 %0, %1, %2, %3" : "=v"(r) : "v"(a), "v"(b), "v"(c)); return r; }
DI int crow(int i, int hh) { return (i & 3) + 8 * (i >> 2) + 4 * hh; }
DI void unpack8(u32x4 v, float (&f)[8]) {
  f[0] = bf_lo(v.x); f[1] = bf_hi(v.x); f[2] = bf_lo(v.y); f[3] = bf_hi(v.y);
  f[4] = bf_lo(v.z); f[5] = bf_hi(v.z); f[6] = bf_lo(v.w); f[7] = bf_hi(v.w);
}
DI u32x4 pack8(const float (&f)[8]) {
  u32x4 r; r.x = pack2(f[0], f[1]); r.y = pack2(f[2], f[3]); r.z = pack2(f[4], f[5]); r.w = pack2(f[6], f[7]); return r;
}
DI void ldstg8(const float* stg, int r, int c8, float (&v)[8]) {
  f32x4 a = *(const f32x4_a*)(stg + r * CST + c8), b = *(const f32x4_a*)(stg + r * CST + c8 + 4);
  v[0] = a.x; v[1] = a.y; v[2] = a.z; v[3] = a.w; v[4] = b.x; v[5] = b.y; v[6] = b.z; v[7] = b.w;
}
DI void zero_acc(f32x16 (&acc)[2][2]) {
#pragma unroll
  for (int a = 0; a < 2; a++)
#pragma unroll
    for (int b = 0; b < 2; b++)
#pragma unroll
      for (int i = 0; i < 16; i++) acc[a][b][i] = 0.f;
}
DI void stage_acc(const f32x16 (&acc)[2][2], float* stg, int tid) {
  const int lane = tid & 63, w = tid >> 6, wr = w >> 1, wc = w & 1, lr = lane & 31, hh = lane >> 5;
#pragma unroll
  for (int ta = 0; ta < 2; ta++)
#pragma unroll
    for (int tb = 0; tb < 2; tb++)
#pragma unroll
      for (int i = 0; i < 16; i++) {
        int row = wr * 64 + ta * 32 + crow(i, hh), col = wc * 64 + tb * 32 + lr;
        stg[row * CST + col] = acc[ta][tb][i];
      }
}

#define PG8_LAS __attribute__((address_space(3)))
namespace pg8 {
constexpr int BM = 256, BK = 64, HALF = 128, HTB = HALF * BK * 2, STAGE_BYTES = 8 * HTB, NXCD = 8, WGM = 8;
DI int lds_byte(int r, int c) { const int st = (r >> 4) * 2 + (c >> 5), rr = r & 15, cc = c & 31, ob = rr * 64 + cc * 2; return st * 1024 + (ob ^ (((ob >> 9) & 1) << 5)); }
DI void stage_rc(int b, int& R, int& C) { const int st = b / 1024, sb = b % 1024, swz = sb ^ (((sb >> 9) & 1) << 5); R = (st >> 1) * 16 + swz / 64; C = (st & 1) * 32 + (swz % 64) / 2; }
DI int perm32(int rho) { const int n = rho >> 4, i = rho & 15; return 8 * (i >> 2) + 4 * n + (i & 3); }
struct Unit { int pm, pn; };

template <class Epi, class Sched>
DI void gemm_phase(PG8_LAS unsigned char* lds, const u16* Abase, const u16* Btbase, const int K, const Sched& S, const Epi& E) {
    const int tid = otid(), wid = __builtin_amdgcn_readfirstlane(tid >> 6), lane = tid & 63, wr = wid >> 2, wc = wid & 3, fr = lane & 15, fq = lane >> 4;
    const int nt = K / BK;
    unsigned voffA[2], voffB[2];
#pragma unroll
    for (int i = 0; i < 2; ++i) { int R, C; stage_rc(tid * 16 + i * 8192, R, C); const int Rb = (R & ~31) + perm32(R & 31);
        voffA[i] = (unsigned)(R * K + C) * 2u; voffB[i] = (unsigned)(Rb * K + C) * 2u; }
    const size_t kstep = (size_t)(BK * 2);
    const size_t hstep = (size_t)HALF * K * 2;
    const size_t tstep = 2 * hstep;
    const unsigned ldsw = (unsigned)wid * 1024u;
    const int aoff = lds_byte(wr * 64 + fr, fq * 8), boff = lds_byte(wc * 32 + fr, fq * 8);
#define PG8_SA(b, h) (((b) * 2 + (h)) * HTB)
#define PG8_SB(b, h) ((4 + (b) * 2 + (h)) * HTB)
#define PG8_STAGE(bufoff, gbase, voff) do { _Pragma("unroll") for (int _i = 0; _i < 2; ++_i) \
        __builtin_amdgcn_global_load_lds((const unsigned*)((const char*)(gbase) + (voff)[_i]), (PG8_LAS unsigned*)(lds + (bufoff) + ldsw + _i * 8192), 16, 0, 0); } while (0)
#define PG8_LDA(dst, b, h) do { _Pragma("unroll") for (int m = 0; m < 4; ++m) _Pragma("unroll") for (int k = 0; k < 2; ++k) dst[m][k] = *(const PG8_LAS bf16x8*)(lds + PG8_SA(b, h) + aoff + m * 2048 + k * 1024); } while (0)
#define PG8_LDB(dst, b, h) do { _Pragma("unroll") for (int n = 0; n < 2; ++n) _Pragma("unroll") for (int k = 0; k < 2; ++k) dst[n][k] = *(const PG8_LAS bf16x8*)(lds + PG8_SB(b, h) + boff + n * 2048 + k * 1024); } while (0)
#define PG8_MMA(ai, bj, At, Bt) do { __builtin_amdgcn_s_setprio(1); _Pragma("unroll") for (int m = 0; m < 4; ++m) _Pragma("unroll") for (int n = 0; n < 2; ++n) _Pragma("unroll") for (int k = 0; k < 2; ++k) \
        acc[ai][bj][m][n] = __builtin_amdgcn_mfma_f32_16x16x32_bf16(Bt[n][k], At[m][k], acc[ai][bj][m][n], 0, 0, 0); __builtin_amdgcn_s_setprio(0); } while (0)
#define PG8_WAIT_V(n) asm volatile("s_waitcnt vmcnt(" #n ")" ::: "memory")
#define PG8_WAIT_L(n) asm volatile("s_waitcnt lgkmcnt(" #n ")" ::: "memory")
#define PG8_BAR __builtin_amdgcn_s_barrier()
#define PG8_SCHED __builtin_amdgcn_sched_barrier(0)
    Unit cur, nxt; int ui = 0;
    if (!S.next(0, cur)) return;
    f32x4 acc[2][2][4][2];
#pragma unroll
    for (int a = 0; a < 2; ++a)
#pragma unroll
        for (int b = 0; b < 2; ++b)
#pragma unroll
            for (int m = 0; m < 4; ++m)
#pragma unroll
                for (int n = 0; n < 2; ++n) acc[a][b][m][n] = (f32x4){0.f, 0.f, 0.f, 0.f};
    bf16x8 At[4][2], B0[2][2], B1[2][2];
    const char* cA = (const char*)Abase + (size_t)cur.pm * tstep; const char* cB = (const char*)Btbase + (size_t)cur.pn * tstep;
    PG8_STAGE(PG8_SB(0, 0), cB, voffB); PG8_STAGE(PG8_SA(0, 0), cA, voffA); PG8_STAGE(PG8_SB(0, 1), cB + hstep, voffB); PG8_STAGE(PG8_SA(0, 1), cA + hstep, voffA);
    if (wr == 1) PG8_BAR;
    PG8_WAIT_V(4); PG8_BAR;
    PG8_STAGE(PG8_SB(1, 0), cB + kstep, voffB); PG8_STAGE(PG8_SA(1, 0), cA + kstep, voffA); PG8_STAGE(PG8_SB(1, 1), cB + hstep + kstep, voffB);
    PG8_WAIT_V(6); PG8_BAR;
    for (;;) {
        const bool has_next = S.next(ui + 1, nxt);
        const char* nA = has_next ? (const char*)Abase + (size_t)nxt.pm * tstep : cA; const char* nB = has_next ? (const char*)Btbase + (size_t)nxt.pn * tstep : cB;
        for (int t = 0; t < nt; t += 2) {
            const bool last = (t == nt - 2);
            const char* a1 = cA + (size_t)(t + 1) * kstep;
            const char* a2 = last ? nA : cA + (size_t)(t + 2) * kstep; const char* b2 = last ? nB : cB + (size_t)(t + 2) * kstep;
            const char* a3 = a2 + kstep; const char* b3 = b2 + kstep;
            PG8_LDB(B0, 0, 0); PG8_SCHED; PG8_LDA(At, 0, 0); PG8_STAGE(PG8_SA(1, 1), a1 + hstep, voffA);
            PG8_WAIT_L(8); PG8_BAR; PG8_WAIT_L(0); PG8_MMA(0, 0, At, B0); PG8_BAR; PG8_SCHED;
            PG8_LDB(B1, 0, 1); PG8_STAGE(PG8_SB(0, 0), b2, voffB);
            PG8_BAR; PG8_WAIT_L(0); PG8_MMA(0, 1, At, B1); PG8_BAR;
            PG8_LDA(At, 0, 1); PG8_STAGE(PG8_SA(0, 0), a2, voffA);
            PG8_BAR; PG8_WAIT_L(0); PG8_MMA(1, 0, At, B0); PG8_BAR; PG8_SCHED;
            PG8_STAGE(PG8_SB(0, 1), b2 + hstep, voffB);
            PG8_WAIT_V(6); PG8_BAR; PG8_MMA(1, 1, At, B1); PG8_BAR;
            PG8_LDB(B0, 1, 0); PG8_SCHED; PG8_LDA(At, 1, 0); PG8_STAGE(PG8_SA(0, 1), a2 + hstep, voffA);
            PG8_WAIT_L(8); PG8_BAR; PG8_WAIT_L(0); PG8_MMA(0, 0, At, B0); PG8_BAR; PG8_SCHED;
            PG8_LDB(B1, 1, 1); PG8_STAGE(PG8_SB(1, 0), b3, voffB);
            PG8_BAR; PG8_WAIT_L(0); PG8_MMA(0, 1, At, B1); PG8_BAR;
            PG8_LDA(At, 1, 1); PG8_STAGE(PG8_SA(1, 0), a3, voffA);
            PG8_BAR; PG8_WAIT_L(0); PG8_MMA(1, 0, At, B0); PG8_BAR; PG8_SCHED;
            PG8_STAGE(PG8_SB(1, 1), b3 + hstep, voffB);
            PG8_WAIT_V(6); PG8_BAR; PG8_MMA(1, 1, At, B1); PG8_BAR;
        }
        bool keep = false;
        if constexpr (Epi::CHAIN) keep = E(acc, cur, wr, wc, fr, fq); else E(acc, cur, wr, wc, fr, fq);
        if (!has_next) break;
        if (!keep) {
#pragma unroll
        for (int a = 0; a < 2; ++a)
#pragma unroll
            for (int b = 0; b < 2; ++b)
#pragma unroll
                for (int m = 0; m < 4; ++m)
#pragma unroll
                    for (int n = 0; n < 2; ++n) acc[a][b][m][n] = (f32x4){0.f, 0.f, 0.f, 0.f};
        }
        cur = nxt; cA = nA; cB = nB; ++ui;
    }
    PG8_WAIT_V(0);
    if (wr == 0) PG8_BAR;
    PG8_BAR;
#undef PG8_SA
#undef PG8_SB
#undef PG8_STAGE
#undef PG8_LDA
#undef PG8_LDB
#undef PG8_MMA
#undef PG8_WAIT_V
#undef PG8_WAIT_L
#undef PG8_BAR
#undef PG8_SCHED
}

DI void grid_map(int L, int nM, int nN, int& pm, int& pn) {
    const int nwg = nM * nN;
    int wgid = L; { const int q = nwg / NXCD, r = nwg % NXCD, xcd = wgid % NXCD, off = wgid / NXCD; wgid = (xcd < r ? xcd * (q + 1) : r * (q + 1) + (xcd - r) * q) + off; }
    const int nig = WGM * nN, gid = wgid / nig, fm = gid * WGM, gsz = (nM - fm) < WGM ? (nM - fm) : WGM;
    pm = fm + ((wgid % nig) % gsz); pn = (wgid % nig) / gsz;
}
struct GridOrder {
    int nM, nN, nwg, G, c;
    DI void init(int nM_, int nN_, int G_, int c_) { nM = nM_; nN = nN_; nwg = nM * nN; G = G_; c = c_; }
    DI bool next(int i, Unit& u) const {
        const int L = i * G + c; if (L >= nwg) return false;
        int wgid = L; { const int q = nwg / NXCD, r = nwg % NXCD, xcd = wgid % NXCD, off = wgid / NXCD; wgid = (xcd < r ? xcd * (q + 1) : r * (q + 1) + (xcd - r) * q) + off; }
        const int nig = WGM * nN, gid = wgid / nig, fm = gid * WGM, gsz = (nM - fm) < WGM ? (nM - fm) : WGM;
        u.pm = fm + ((wgid % nig) % gsz); u.pn = (wgid % nig) / gsz; return true;
    }
};
}

DI void acc8(const f32x4 (&acc)[2][2][4][2], int ai, int bj, int m, float (&v)[8]) {
  f32x4 a = acc[ai][bj][m][0], b = acc[ai][bj][m][1];
  v[0] = a.x; v[1] = a.y; v[2] = a.z; v[3] = a.w; v[4] = b.x; v[5] = b.y; v[6] = b.z; v[7] = b.w;
}
DI void rope8v(float (&v)[8], f32x4 t0, f32x4 t1) {
  float a, b;
  a = v[0]; b = v[1]; v[0] = a * t0.x - b * t0.y; v[1] = a * t0.y + b * t0.x;
  a = v[2]; b = v[3]; v[2] = a * t0.z - b * t0.w; v[3] = a * t0.w + b * t0.z;
  a = v[4]; b = v[5]; v[4] = a * t1.x - b * t1.y; v[5] = a * t1.y + b * t1.x;
  a = v[6]; b = v[7]; v[6] = a * t1.z - b * t1.w; v[7] = a * t1.w + b * t1.z;
}

DI void rope8(float (&v)[8], const float* tb) { rope8v(v, *(const f32x4_a*)tb, *(const f32x4_a*)(tb + 4)); }

template <int KIND>
DI void g1_body(const Params& P, const f32x4 (&acc)[2][2][4][2], const pg8::Unit& u, int wr, int wc, int fr, int fq,
                u16* dbase, int ldo, int coff, float* sbase) {
  const int lane = otid() & 63;
  const bool lat = u.pm < 64;
  f32x4 rt[2][4][2];
  if ((KIND == 0 || KIND == 1 || KIND == 7) && lat) {
    const int o = 32 * wc + 8 * fq;
    const int axis = (KIND == 7) ? ((o & 63) >> 5) : (o >> 6);
    const int i0 = (KIND == 7) ? ((o & 31) >> 1) : ((o & 63) >> 1);
    const float* tbase = (KIND == 7) ? P.tab16() : P.tab32();
    const int half = (KIND == 7) ? 16 : 32;
#pragma unroll
    for (int ai = 0; ai < 2; ai++)
#pragma unroll
      for (int m = 0; m < 4; m++) {
        const int pos = (u.pm * 256 + ai * 128 + wr * 64 + m * 16 + fr) & 4095;
        const int p = axis ? (pos & 63) : (pos >> 6);
        const float* tb = tbase + (size_t)(p * half + i0) * 2;
        rt[ai][m][0] = *(const f32x4_a*)tb; rt[ai][m][1] = *(const f32x4_a*)(tb + 4);
      }
    __builtin_amdgcn_sched_barrier(0);
  }
#pragma unroll
  for (int ai = 0; ai < 2; ai++) {
#pragma unroll
    for (int m = 0; m < 4; m++) {
      const int tok = u.pm * 256 + ai * 128 + wr * 64 + m * 16 + fr;
      const int pos = tok & 4095;
      const int b = lat ? (tok >> 12) : ((tok - NLAT) >> 8);
      float s1 = 0.f, s2 = 0.f;
#pragma unroll
      for (int bj = 0; bj < 2; bj++) {
        float v[8]; acc8(acc, ai, bj, m, v);
        const int o = 32 * wc + 8 * fq;
        const int c0 = 128 * bj + o;
        if (KIND == 0 || KIND == 1) {
          if (lat) rope8v(v, rt[ai][m][0], rt[ai][m][1]);
          st16(dbase + (size_t)tok * ldo + coff + c0, pack8(v));
        } else if (KIND == 2) {
          u16* dst = lat ? P.vTa_lat() + ((size_t)(b * 2 + bj) * 128 + o) * 4096 + vperm(pos)
                         : P.vTa_ctx() + ((size_t)(b * 2 + bj) * 128 + o) * 256 + vperm((tok - NLAT) & 255);
          const size_t ld = lat ? 4096 : 256;
#pragma unroll
          for (int j = 0; j < 4; j++) { const unsigned pw = pack2(v[2 * j], v[2 * j + 1]); dst[(2 * j) * ld] = (u16)pw; dst[(2 * j + 1) * ld] = (u16)(pw >> 16); }
        } else if (KIND == 3) {
#pragma unroll
          for (int j = 0; j < 8; j++) v[j] = siluf(v[j]);
          st16(dbase + (size_t)tok * ldo + coff + c0, pack8(v));
        } else if (KIND == 4) {
          st16(dbase + (size_t)tok * ldo + coff + c0, pack8(v));
#pragma unroll
          for (int j = 0; j < 8; j++) s2 += v[j] * v[j];
        } else if (KIND == 5) {
          st16(dbase + (size_t)tok * ldo + coff + c0, pack8(v));
        } else if (KIND == 6) {
          u16* dst = P.cvT() + ((size_t)(tok >> 7) * 1024 + coff + c0) * 128 + (tok & 127);
#pragma unroll
          for (int j = 0; j < 4; j++) { const unsigned pw = pack2(v[2 * j], v[2 * j + 1]); dst[(2 * j) * 128] = (u16)pw; dst[(2 * j + 1) * 128] = (u16)(pw >> 16); }
#pragma unroll
          for (int j = 0; j < 8; j++) { s1 += v[j]; s2 += v[j] * v[j]; }
        } else if (KIND == 7) {
          if (c0 < 64) {
            if (lat) rope8v(v, rt[ai][m][0], rt[ai][m][1]);
            st16(P.kr() + (size_t)tok * 64 + c0, pack8(v));
          }
        } else {
#pragma unroll
          for (int j = 0; j < 8; j++) v[j] = 1.f + __expf(fminf(-v[j], 69.f));
          st16(dbase + (size_t)tok * ldo + coff + c0, pack8(v));
        }
      }
      if (KIND == 4) {
        s2 += shx(s2, lane, 16); s2 += shx(s2, lane, 32);
        if (fq == 0) sbase[(size_t)tok * 8 + wc] = s2;
      } else if (KIND == 6) {
        s1 += shx(s1, lane, 16); s1 += shx(s1, lane, 32);
        s2 += shx(s2, lane, 16); s2 += shx(s2, lane, 32);
        if (fq == 0) { float* d = sbase + ((size_t)tok * 16 + wc) * 2; d[0] = s1; d[1] = s2; }
      }
    }
  }
}
struct EpiG1 {
  static constexpr bool CHAIN = false;
  const Params& P;
  DI void operator()(const f32x4 (&acc)[2][2][4][2], const pg8::Unit& u, int wr, int wc, int fr, int fq) const {
    asm volatile("" : "+v"(fr), "+v"(fq));
    const int pn = u.pn;
    if (pn < 4) g1_body<0>(P, acc, u, wr, wc, fr, fq, P.q_a(), 1024, pn * 256, nullptr);
    else if (pn == 4) g1_body<1>(P, acc, u, wr, wc, fr, fq, P.k_a(), 256, 0, nullptr);
    else if (pn == 5) g1_body<2>(P, acc, u, wr, wc, fr, fq, nullptr, 0, 0, nullptr);
    else if (pn < 10) g1_body<3>(P, acc, u, wr, wc, fr, fq, P.saz(), 1024, (pn - 6) * 256, nullptr);
    else if (pn < 12) g1_body<4>(P, acc, u, wr, wc, fr, fq, P.cq(), 512, (pn - 10) * 256, P.ssq_q() + (pn - 10) * 4);
    else if (pn < 14) g1_body<4>(P, acc, u, wr, wc, fr, fq, P.ckv(), 512, (pn - 12) * 256, P.ssq_kv() + (pn - 12) * 4);
    else if (pn < 18) g1_body<3>(P, acc, u, wr, wc, fr, fq, P.sbz(), 1024, (pn - 14) * 256, nullptr);
    else if (pn < 22) g1_body<5>(P, acc, u, wr, wc, fr, fq, P.cu(), 1024, (pn - 18) * 256, nullptr);
    else if (pn < 26) g1_body<6>(P, acc, u, wr, wc, fr, fq, nullptr, 0, (pn - 22) * 256, P.cvst() + (pn - 22) * 8);
    else if (pn < 30) g1_body<3>(P, acc, u, wr, wc, fr, fq, P.scz(), 1024, (pn - 26) * 256, nullptr);
    else if (pn == 30) g1_body<7>(P, acc, u, wr, wc, fr, fq, nullptr, 0, 0, nullptr);
    else g1_body<8>(P, acc, u, wr, wc, fr, fq, P.sg(), 6144, (pn - 31) * 256, nullptr);
  }
};

struct EpiG2 {
  static constexpr bool CHAIN = false;
  const Params& P;
  DI void operator()(const f32x4 (&acc)[2][2][4][2], const pg8::Unit& u, int wr, int wc, int fr, int fq) const {
    asm volatile("" : "+v"(fr), "+v"(fq));
    const bool isq = u.pm < 68;
    const int pm = isq ? u.pm : u.pm - 68;
    const bool lat = pm < 64;
    float rsv[2][4];
    {
      f32x4 p0[2][4], p1[2][4];
#pragma unroll
      for (int ai = 0; ai < 2; ai++)
#pragma unroll
        for (int m = 0; m < 4; m++) {
          const int tok = pm * 256 + ai * 128 + wr * 64 + m * 16 + fr;
          const float* sp = (isq ? P.ssq_q() : P.ssq_kv()) + (size_t)tok * 8;
          p0[ai][m] = *(const f32x4_a*)sp; p1[ai][m] = *(const f32x4_a*)(sp + 4);
        }
      __builtin_amdgcn_sched_barrier(0);
#pragma unroll
      for (int ai = 0; ai < 2; ai++)
#pragma unroll
        for (int m = 0; m < 4; m++) {
          f32x4 a = p0[ai][m], b = p1[ai][m];
          rsv[ai][m] = rsqrtf((a.x + a.y + a.z + a.w + b.x + b.y + b.z + b.w) * (1.f / 512.f) + EPS);
        }
    }
#pragma unroll
    for (int ai = 0; ai < 2; ai++) {
#pragma unroll
      for (int m = 0; m < 4; m++) {
        const int tok = pm * 256 + ai * 128 + wr * 64 + m * 16 + fr;
        const int pos = tok & 4095;
        const int b = lat ? (tok >> 12) : ((tok - NLAT) >> 8);
        const float rs = rsv[ai][m];
#pragma unroll
        for (int bj = 0; bj < 2; bj++) {
          float v[8]; acc8(acc, ai, bj, m, v);
#pragma unroll
          for (int j = 0; j < 8; j++) v[j] *= rs;
          const int o = 32 * wc + 8 * fq, c0 = 128 * bj + o;
          if (isq) {
            const int n0 = u.pn * 256 + c0;
            const int hd = n0 % 192;
            if (lat && hd >= 128) {
              const int oo = hd - 128;
              const int axis = oo >> 5, i0 = (oo & 31) >> 1;
              const int p = axis ? (pos & 63) : (pos >> 6);
              rope8(v, P.tab16() + (size_t)(p * 16 + i0) * 2);
            }
            st16(P.q_b() + (size_t)tok * 1536 + n0, pack8(v));
          } else {
            const int head = u.pn - 6;
            if (bj == 0) {
              st16(P.kn_b() + (size_t)tok * 1024 + head * 128 + o, pack8(v));
            } else {
              u16* dst = lat ? P.vTb_lat() + ((size_t)(b * 8 + head) * 128 + o) * 4096 + vperm(pos)
                             : P.vTb_ctx() + ((size_t)(b * 8 + head) * 128 + o) * 256 + vperm((tok - NLAT) & 255);
              const size_t ld = lat ? 4096 : 256;
#pragma unroll
              for (int j = 0; j < 4; j++) { const unsigned pw = pack2(v[2 * j], v[2 * j + 1]); dst[(2 * j) * ld] = (u16)pw; dst[(2 * j + 1) * ld] = (u16)(pw >> 16); }
            }
          }
        }
      }
    }
  }
};
struct OrderG1 {
  int G, c, l;
  DI bool next(int i, pg8::Unit& u) const {
    const int L = i * G + c;
    if (l == 0) { if (L >= 68 * 55) return false; pg8::grid_map(L, 68, 55, u.pm, u.pn); return true; }
    if (L < 64 * 55) { pg8::grid_map(L, 64, 55, u.pm, u.pn); return true; }
    const int j = L - 64 * 55;
    if (j >= 20) return false;
    const int q = j >> 2;
    u.pm = 64 + (j & 3); u.pn = (q == 0) ? 4 : (q == 1) ? 5 : (q == 2) ? 12 : (q == 3) ? 13 : 30;
    return true;
  }
};
struct OrderG2 {
  int G, c, l;
  DI bool next(int i, pg8::Unit& u) const {
    const int L = i * G + c;
    const int nq = (l == 0) ? 408 : 384;
    if (L < nq) { pg8::grid_map(L, (l == 0) ? 68 : 64, 6, u.pm, u.pn); return true; }
    const int L2 = L - nq;
    if (L2 < 544) { pg8::grid_map(L2, 68, 8, u.pm, u.pn); u.pm += 68; u.pn += 6; return true; }
    return false;
  }
};

struct EpiG3 {
  static constexpr bool CHAIN = true;
  const Params& P;
  DI bool operator()(f32x4 (&acc)[2][2][4][2], const pg8::Unit& u, int wr, int wc, int fr, int fq) const {
    asm volatile("" : "+v"(fr), "+v"(fq));
    const int br = u.pm / 68, pm = u.pm - br * 68, pn = u.pn & 7;
    const int col = pn * 256 + 32 * wc + 8 * fq;
#pragma unroll
    for (int ai = 0; ai < 2; ai++) {
      const int tok0 = pm * 256 + ai * 128 + wr * 64 + fr;
      const u16* gp = P.sg() + (size_t)tok0 * 6144 + br * 2048 + col;
      u32x4 G[4][2], H[4][2];
#pragma unroll
      for (int m = 0; m < 4; m++)
#pragma unroll
        for (int bj = 0; bj < 2; bj++) {
          G[m][bj] = ld16(gp + (size_t)m * 16 * 6144 + bj * 128);
          H[m][bj] = (br < 2) ? ld16(gp + (size_t)m * 16 * 6144 + bj * 128 + 2048) : G[m][bj];
        }
      __builtin_amdgcn_sched_barrier(0);
#pragma unroll
      for (int m = 0; m < 4; m++)
#pragma unroll
        for (int bj = 0; bj < 2; bj++) {
          float g[8]; unpack8(G[m][bj], g);
#pragma unroll
          for (int j = 0; j < 8; j++) g[j] = __builtin_amdgcn_rcpf(g[j]);
          if (br < 2) {
            float g2[8]; unpack8(H[m][bj], g2);
#pragma unroll
            for (int j = 0; j < 8; j++) g[j] *= g2[j];
          }
          f32x4 a0 = acc[ai][bj][m][0], a1 = acc[ai][bj][m][1];
          a0.x *= g[0]; a0.y *= g[1]; a0.z *= g[2]; a0.w *= g[3]; a1.x *= g[4]; a1.y *= g[5]; a1.z *= g[6]; a1.w *= g[7];
          if (br < 2) { acc[ai][bj][m][0] = a0; acc[ai][bj][m][1] = a1; }
          else {
            u32x4 w; w.x = pack2(a0.x, a0.y); w.y = pack2(a0.z, a0.w); w.z = pack2(a1.x, a1.y); w.w = pack2(a1.z, a1.w);
            st16(P.m() + (size_t)(tok0 + m * 16) * DM + col + bj * 128, w);
          }
        }
    }
    return br < 2;
  }
};
struct OrderG3 {
  int G, c, MTu;
  DI bool next(int i, pg8::Unit& u) const {
    const int rt = i / 3, br = i - rt * 3;
    const int tI = rt * G + c;
    if (tI >= MTu * 8) return false;
    int pm, pn; pg8::grid_map(tI, MTu, 8, pm, pn);
    u.pm = br * 68 + pm; u.pn = br * 8 + pn; return true;
  }
};

struct EpiG4 {
  static constexpr bool CHAIN = false;
  const Params& P; int l;
  DI void operator()(const f32x4 (&acc)[2][2][4][2], const pg8::Unit& u, int wr, int wc, int fr, int fq) const {
    asm volatile("" : "+v"(fr), "+v"(fq));
    const bool lat = u.pm < 64;
    const int mrow = lat ? (u.pm >> 4) : 4;
    const int col = u.pn * 256 + 32 * wc + 8 * fq;
    const float* gp = P.mod() + (size_t)(l * 5 + mrow) * 6144 + 4096 + col;
    f32x4 gv[2][2];
#pragma unroll
    for (int bj = 0; bj < 2; bj++) { gv[bj][0] = *(const f32x4_a*)(gp + bj * 128); gv[bj][1] = *(const f32x4_a*)(gp + bj * 128 + 4); }
#pragma unroll
    for (int ai = 0; ai < 2; ai++) {
      const int tok0 = u.pm * 256 + ai * 128 + wr * 64 + fr;
      const float* xin = (l == 0) ? (lat ? P.x + (size_t)tok0 * DM : P.ctx + (size_t)(tok0 - NLAT) * DM)
                                  : (lat ? P.out + (size_t)tok0 * DM : P.xres() + (size_t)(tok0 - NLAT) * DM);
      float* xo = lat ? P.out + (size_t)tok0 * DM : P.xres() + (size_t)(tok0 - NLAT) * DM;
      f32x4 X[4][2][2];
#pragma unroll
      for (int m = 0; m < 4; m++)
#pragma unroll
        for (int bj = 0; bj < 2; bj++) {
          X[m][bj][0] = *(const f32x4_a*)(xin + (size_t)m * 16 * DM + col + bj * 128);
          X[m][bj][1] = *(const f32x4_a*)(xin + (size_t)m * 16 * DM + col + bj * 128 + 4);
        }
      __builtin_amdgcn_sched_barrier(0);
#pragma unroll
      for (int m = 0; m < 4; m++)
#pragma unroll
        for (int bj = 0; bj < 2; bj++) {
          *(f32x4_a*)(xo + (size_t)m * 16 * DM + col + bj * 128) = X[m][bj][0] + gv[bj][0] * acc[ai][bj][m][0];
          *(f32x4_a*)(xo + (size_t)m * 16 * DM + col + bj * 128 + 4) = X[m][bj][1] + gv[bj][1] * acc[ai][bj][m][1];
        }
    }
  }
};

DI int win_src(int n) {
  if (n < 1280) {
    int head = n >> 7, p = n & 127, blk = p >> 6, q = p & 63;
    return head * 128 + blk * 64 + (q & 1) * 32 + (q >> 1);
  }
  if (n < 3584) return n;
  if (n < 7680) return n + 64;
  if (n < 7744) { int p = n - 7680, blk = p >> 5, q = p & 31; return 3584 + blk * 32 + (q & 1) * 16 + (q >> 1); }
  if (n < 7936) return -1;
  return n - 192;
}
DI int uq_src(int n) {
  int head = n / 192, p = n - head * 192;
  if (p < 128) return n;
  int pp = p - 128, blk = pp >> 5, q = pp & 31;
  return head * 192 + 128 + blk * 32 + (q & 1) * 16 + (q >> 1);
}
template <int MAP>
DI void transpose_item(const float* __restrict__ src, int ld_src, int k0, int n0, const float* kscale,
                       u16* __restrict__ dst, int K, char* smem, int tid) {
  float* tl = (float*)smem;
  const int kk0 = tid >> 6;
  const bool vec = (MAP == 0) || (MAP == 1 && n0 >= 1280 && n0 != 7680);
  if (vec) {
    const int nq = tid & 63;
    int sc = n0 + nq * 4;
    if (MAP == 1) sc = win_src(sc);
    f32x4 v4[16];
#pragma unroll
    for (int i = 0; i < 16; i++) v4[i] = *(const f32x4_a*)(src + (size_t)(k0 + kk0 + 4 * i) * ld_src + sc);
    const int q = nq >> 4, nn = (nq & 15) * 4;
#pragma unroll
    for (int i = 0; i < 16; i++) {
      int kk = kk0 + 4 * i;
      float ksc = kscale ? kscale[k0 + kk] : 1.f;
      float* d = tl + (q * 64 + kk) * 65 + nn;
      d[0] = v4[i].x * ksc; d[1] = v4[i].y * ksc; d[2] = v4[i].z * ksc; d[3] = v4[i].w * ksc;
    }
  } else {
    const int nn = tid & 63;
    float v[4][16];
#pragma unroll
    for (int q = 0; q < 4; q++) {
      int sc = n0 + q * 64 + nn;
      if (MAP == 1) sc = win_src(sc);
      if (MAP == 2) sc = uq_src(sc);
#pragma unroll
      for (int i = 0; i < 16; i++) {
        int kk = kk0 + 4 * i;
        v[q][i] = (sc < 0) ? 0.f : src[(size_t)(k0 + kk) * ld_src + sc];
      }
    }
#pragma unroll
    for (int q = 0; q < 4; q++)
#pragma unroll
      for (int i = 0; i < 16; i++) {
        int kk = kk0 + 4 * i;
        float x = v[q][i];
        if (kscale) x *= kscale[k0 + kk];
        tl[(q * 64 + kk) * 65 + nn] = x;
      }
  }
  __syncthreads();
  const int n = tid >> 2, ks = (tid & 3) * 16;
#pragma unroll
  for (int q = 0; q < 4; q++) {
    const float* t = tl + (q * 64) * 65;
    u32x4 o0, o1;
    o0.x = pack2(t[(ks + 0) * 65 + n], t[(ks + 1) * 65 + n]);
    o0.y = pack2(t[(ks + 2) * 65 + n], t[(ks + 3) * 65 + n]);
    o0.z = pack2(t[(ks + 4) * 65 + n], t[(ks + 5) * 65 + n]);
    o0.w = pack2(t[(ks + 6) * 65 + n], t[(ks + 7) * 65 + n]);
    o1.x = pack2(t[(ks + 8) * 65 + n], t[(ks + 9) * 65 + n]);
    o1.y = pack2(t[(ks + 10) * 65 + n], t[(ks + 11) * 65 + n]);
    o1.z = pack2(t[(ks + 12) * 65 + n], t[(ks + 13) * 65 + n]);
    o1.w = pack2(t[(ks + 14) * 65 + n], t[(ks + 15) * 65 + n]);
    u16* d = dst + (size_t)(n0 + q * 64 + n) * K + k0 + ks;
    st16(d, o0); st16(d + 8, o1);
  }
  __syncthreads();
}

DI void ada_item(const Params& P, int it, char* smem) {
  const int tid = otid() & 255;
  const int l = it / 192, cc = it % 192;
  float* sc = (float*)smem;
  for (int i = tid; i < 5 * 2048; i += 256) {
    int r = i >> 11, k = i & 2047;
    float v = (r < 4) ? P.c[r * 2048 + k] : P.c_ctx[k];
    sc[i] = v / (1.f + expf(-v));
  }
  __syncthreads();
  const int cl = tid & 31, kg = tid >> 5;
  const float* wp = P.ada_w + (size_t)l * 2048 * 6144 + cc * 32 + cl;
  float a0 = 0.f, a1 = 0.f, a2 = 0.f, a3 = 0.f, a4 = 0.f;
#pragma unroll 8
  for (int k = kg * 256; k < kg * 256 + 256; k++) {
    float wv = wp[(size_t)k * 6144];
    a0 += wv * sc[k]; a1 += wv * sc[2048 + k]; a2 += wv * sc[4096 + k]; a3 += wv * sc[6144 + k]; a4 += wv * sc[8192 + k];
  }
  float* red = (float*)(smem + 40960);
  red[(kg * 5 + 0) * 32 + cl] = a0; red[(kg * 5 + 1) * 32 + cl] = a1; red[(kg * 5 + 2) * 32 + cl] = a2;
  red[(kg * 5 + 3) * 32 + cl] = a3; red[(kg * 5 + 4) * 32 + cl] = a4;
  __syncthreads();
  if (tid < 160) {
    int r = tid >> 5, c2 = tid & 31;
    float s = 0.f;
    for (int g = 0; g < 8; g++) s += red[(g * 5 + r) * 32 + c2];
    P.mod()[(size_t)(l * 5 + r) * 6144 + cc * 32 + c2] = s + P.ada_b[l * 6144 + cc * 32 + c2];
  }
  __syncthreads();
}


constexpr int W_ADA = 384, W_SGU = 128, W_TAB = 2;
constexpr int W_PRE = W_ADA + W_SGU + W_TAB;
constexpr int W_L_WIN = 55 * 32, W_L_UQ = 6 * 8, W_L_UKV = 8 * 8, W_L_WP = 3 * 8 * 16, W_L_WOUT = 8 * 32;
constexpr int W_L = W_L_WIN + W_L_UQ + W_L_UKV + W_L_WP + W_L_WOUT;

DI void phase_w(const Params& P, int l, int bid, int nb, char* smem0) {
  const int half = otid() >> 8, tid = otid() & 255;
  char* smem = smem0 + half * HALF_SMEM;
  const int pre = (l == 0) ? W_PRE : 0;
  const int total = pre + W_L;
  for (int it2 = bid; it2 * 2 < total; it2 += nb) {
    const int it = it2 * 2 + half;
    if (it < pre) {
      if (it < W_ADA) { ada_item(P, it, smem); continue; }
      int i = it - W_ADA;
      if (i < W_SGU) {
        size_t base = (size_t)i * 2048 + tid * 8;
        f32x4 a = *(const f32x4_a*)(P.sgu_w + base), b = *(const f32x4_a*)(P.sgu_w + base + 4);
        u32x4 o; o.x = pack2(a.x, a.y); o.y = pack2(a.z, a.w); o.z = pack2(b.x, b.y); o.w = pack2(b.z, b.w);
        st16(P.SguW() + base, o);
        continue;
      }
      i -= W_SGU;
      if (i == 0) {
        for (int e = tid; e < 64 * 32; e += 256) {
          int pos = e >> 5, fi = e & 31;
          float inv = powf(10000.f, -(float)fi / 32.f);
          float ang = (float)pos * inv;
          P.tab32()[e * 2] = cosf(ang); P.tab32()[e * 2 + 1] = sinf(ang);
        }
      } else {
        for (int e = tid; e < 64 * 16; e += 256) {
          int pos = e >> 4, fi = e & 15;
          float inv = powf(10000.f, -(float)fi / 16.f);
          float ang = (float)pos * inv;
          P.tab16()[e * 2] = cosf(ang); P.tab16()[e * 2 + 1] = sinf(ang);
        }
      }
      continue;
    }
    int i = it - pre;
    if (i < W_L_WIN) {
      int nbk = i >> 5, kb = i & 31;
      transpose_item<1>(P.w_in + (size_t)l * 2048 * 13888, 13888, kb * 64, nbk * 256, nullptr, P.WinT(), 2048, smem, tid);
      continue;
    }
    i -= W_L_WIN;
    if (i < W_L_UQ) {
      int nbk = i >> 3, kb = i & 7;
      transpose_item<2>(P.w_uq + (size_t)l * 512 * 1536, 1536, kb * 64, nbk * 256, P.mla_gq + l * 512, P.WuqT(), 512, smem, tid);
      continue;
    }
    i -= W_L_UQ;
    if (i < W_L_UKV) {
      int nbk = i >> 3, kb = i & 7;
      transpose_item<0>(P.w_ukv + (size_t)l * 512 * 2048, 2048, kb * 64, nbk * 256, P.mla_gkv + l * 512, P.WukvT(), 512, smem, tid);
      continue;
    }
    i -= W_L_UKV;
    if (i < W_L_WP) {
      int br = i / 128, j = i % 128;
      int nbk = j >> 4, kb = j & 15;
      const float* src = (br == 0 ? P.w_pa : (br == 1 ? P.w_pb : P.w_pc)) + (size_t)l * 1024 * 2048;
      transpose_item<0>(src, 2048, kb * 64, nbk * 256, nullptr, P.WpT() + (size_t)br * 2048 * 1024, 1024, smem, tid);
      continue;
    }
    i -= W_L_WP;
    {
      int nbk = i >> 5, kb = i & 31;
      transpose_item<0>(P.w_out + (size_t)l * 2048 * 2048, 2048, kb * 64, nbk * 256, nullptr, P.WoutT(), 2048, smem, tid);
    }
  }
}

DI void phase_norm(const Params& P, int l, int bid, int nb) {
  const int tid = otid(), lane = tid & 63, w = tid >> 6;
  for (int t = bid * 8 + w; t < T_TOK; t += nb * 8) {
    const float* src = (l == 0) ? (t < NLAT ? P.x + (size_t)t * DM : P.ctx + (size_t)(t - NLAT) * DM)
                                : (t < NLAT ? P.out + (size_t)t * DM : P.xres() + (size_t)(t - NLAT) * DM);
    const int mrow = t < NLAT ? (t >> 12) : 4;
    const float* md = P.mod() + (size_t)(l * 5 + mrow) * 6144;
    f32x4 v[8];
    float ss = 0.f;
#pragma unroll
    for (int i = 0; i < 8; i++) {
      v[i] = *(const f32x4_a*)(src + (lane + 64 * i) * 4);
      ss += v[i].x * v[i].x + v[i].y * v[i].y + v[i].z * v[i].z + v[i].w * v[i].w;
    }
#pragma unroll
    for (int o = 32; o >= 1; o >>= 1) ss += shx(ss, lane, o);
    const float rinv = rsqrtf(ss * (1.f / 2048.f) + EPS);
#pragma unroll
    for (int i = 0; i < 8; i++) {
      int c = (lane + 64 * i) * 4;
      f32x4 g = *(const f32x4_a*)(P.norm_g + l * 2048 + c);
      f32x4 sh = *(const f32x4_a*)(md + c);
      f32x4 sc = *(const f32x4_a*)(md + 2048 + c);
      float o0 = v[i].x * rinv * g.x * (1.f + sc.x) + sh.x;
      float o1 = v[i].y * rinv * g.y * (1.f + sc.y) + sh.y;
      float o2 = v[i].z * rinv * g.z * (1.f + sc.z) + sh.z;
      float o3 = v[i].w * rinv * g.w * (1.f + sc.w) + sh.w;
      u32x2 o; o.x = pack2(o0, o1); o.y = pack2(o2, o3);
      *(u32x2_a*)(P.h() + (size_t)t * DM + c) = o;
    }
  }
}

DI void phase_final(const Params& P, int bid, int nb) {
  const int tid = otid(), lane = tid & 63, w = tid >> 6;
  for (int t = bid * 8 + w; t < NLAT; t += nb * 8) {
    float* src = P.out + (size_t)t * DM;
    f32x4 v[8];
    float ss = 0.f;
#pragma unroll
    for (int i = 0; i < 8; i++) {
      v[i] = *(const f32x4_a*)(src + (lane + 64 * i) * 4);
      ss += v[i].x * v[i].x + v[i].y * v[i].y + v[i].z * v[i].z + v[i].w * v[i].w;
    }
#pragma unroll
    for (int o = 32; o >= 1; o >>= 1) ss += shx(ss, lane, o);
    const float rinv = rsqrtf(ss * (1.f / 2048.f) + EPS);
#pragma unroll
    for (int i = 0; i < 8; i++) {
      int c = (lane + 64 * i) * 4;
      f32x4 g = *(const f32x4_a*)(P.final_g + c);
      f32x4 o; o.x = v[i].x * rinv * g.x; o.y = v[i].y * rinv * g.y; o.z = v[i].z * rinv * g.z; o.w = v[i].w * rinv * g.w;
      *(f32x4_a*)(src + c) = o;
    }
  }
}

constexpr int VST = 144;
constexpr int SV_OFF = 25600;

struct AttnArgs {
  const u16* Q; int ldq;
  const u16* K1; int ldk1;
  const u16* K2;
  int seg0_row, seg0_n; const u16* seg0_vT; int seg0_ldv;
  int seg1_row, seg1_n; const u16* seg1_vT; int seg1_ldv;
  int qpos0, kpos0; bool mask0;
  bool has_sink; float sink_l2; float cscale;
  const u16* gate; u16* out;
};

constexpr int ATT_BUF = 45056;
template <int DQK>
DI void attn_item(const AttnArgs& a, char* smem) {
  constexpr int NS = DQK / 16;
  constexpr int KST = DQK * 2 + 16;
  const int tid = otid(), lane = tid & 63, w = tid >> 6, lr = lane & 31, hh = lane >> 5;

  bf16x8 qf[NS];
  {
    const u16* qp = a.Q + (size_t)(w * 32 + lr) * a.ldq + hh * 8;
#pragma unroll
    for (int s = 0; s < NS; s++) qf[s] = *(const bf16x8_a*)(qp + s * 16);
  }
  const int nt0 = a.seg0_n >> 6, ntot = nt0 + (a.seg1_n >> 6);
  u32x4 pk[3], pv[2];
  auto prefetch = [&](int tl) {
    int krow; const u16* vsrc; int ldv;
    if (tl < nt0) { krow = a.seg0_row + tl * 64; vsrc = a.seg0_vT + tl * 64; ldv = a.seg0_ldv; }
    else { int t2 = tl - nt0; krow = a.seg1_row + t2 * 64; vsrc = a.seg1_vT + t2 * 64; ldv = a.seg1_ldv; }
    const u16* p1 = a.K1 + (size_t)(krow + (tid >> 4)) * a.ldk1 + (tid & 15) * 8;
    pk[0] = ld16(p1); pk[1] = ld16(p1 + (size_t)32 * a.ldk1);
    if (DQK == 192) pk[2] = ld16(a.K2 + (size_t)(krow + (tid >> 3)) * 64 + (tid & 7) * 8);
    const u16* p3 = vsrc + (size_t)(tid >> 3) * ldv + (tid & 7) * 8;
    pv[0] = ld16(p3); pv[1] = ld16(p3 + (size_t)64 * ldv);
  };
  auto stash = [&](char* buf) {
    char* sK = buf; char* sV = buf + SV_OFF;
    st16(sK + (tid >> 4) * KST + (tid & 15) * 16, pk[0]);
    st16(sK + ((tid >> 4) + 32) * KST + (tid & 15) * 16, pk[1]);
    if (DQK == 192) st16(sK + (tid >> 3) * KST + 256 + (tid & 7) * 16, pk[2]);
    st16(sV + (tid >> 3) * VST + (tid & 7) * 16, pv[0]);
    st16(sV + ((tid >> 3) + 64) * VST + (tid & 7) * 16, pv[1]);
  };
  f32x16 O[4];
#pragma unroll
  for (int d = 0; d < 4; d++)
#pragma unroll
    for (int i = 0; i < 16; i++) O[d][i] = 0.f;
  float m = a.has_sink ? a.sink_l2 : -1e30f;
  float l = (a.has_sink && hh == 0) ? 1.f : 0.f;
  const int qp = a.qpos0 + w * 32 + lr;
  const int qlo = a.qpos0 + w * 32;

  prefetch(0);
  stash(smem);
  __syncthreads();
  if (ntot > 1) prefetch(1);
  for (int tl = 0; tl < ntot; tl++) {
    const char* sK = smem + (tl & 1) * ATT_BUF;
    const char* sV = sK + SV_OFF;
    const bool domask = a.mask0 && (tl < nt0);
    const int k0 = a.kpos0 + tl * 64;
    const bool skip = domask && ((k0 > qlo + 31 + 128) || (k0 + 63 < qlo - 128));
    if (!skip) {
      f32x16 S0, S1;
#pragma unroll
      for (int i = 0; i < 16; i++) { S0[i] = 0.f; S1[i] = 0.f; }
      {
        constexpr int NC = NS / 4;
        const char* kp0 = sK + lr * KST + hh * 16;
        const char* kp1 = kp0 + 32 * KST;
        bf16x8 ka[4], kb[4];
        __builtin_amdgcn_s_setprio(1);
#pragma unroll
        for (int s = 0; s < 4; s++) ka[s] = *(const bf16x8_a*)(kp0 + s * 32);
#pragma unroll
        for (int s = 0; s < 4; s++) kb[s] = *(const bf16x8_a*)(kp1 + s * 32);
        __builtin_amdgcn_sched_barrier(0);
#pragma unroll
        for (int c = 0; c < NC; c++) {
#pragma unroll
          for (int s = 0; s < 4; s++) {
            S0 = mfma32(ka[s], qf[c * 4 + s], S0);
            S1 = mfma32(kb[s], qf[c * 4 + s], S1);
            if (c + 1 < NC) {
              ka[s] = *(const bf16x8_a*)(kp0 + ((c + 1) * 4 + s) * 32);
              kb[s] = *(const bf16x8_a*)(kp1 + ((c + 1) * 4 + s) * 32);
            }
          }
          __builtin_amdgcn_sched_barrier(0);
        }
        __builtin_amdgcn_s_setprio(0);
      }
      if (domask) {
        const int kbase = k0 - qp;
#pragma unroll
        for (int i = 0; i < 16; i++) {
          int d0 = kbase + crow(i, hh), d1 = d0 + 32;
          if (d0 > 128 || d0 < -128) S0[i] = -1e30f;
          if (d1 > 128 || d1 < -128) S1[i] = -1e30f;
        }
      }
      const float m0 = fmaxf(S1[14], S1[15]);
      float mA = max3f(m0, S0[0], S0[1]), mB = max3f(m0, S1[0], S1[1]);
#pragma unroll
      for (int i = 1; i < 8; i++) mA = max3f(mA, S0[2 * i], S0[2 * i + 1]);
#pragma unroll
      for (int i = 1; i < 7; i++) mB = max3f(mB, S1[2 * i], S1[2 * i + 1]);
      float mx = max3f(mA, mB, mB);
      mx = fmaxf(mx, shx(mx, lane, 32)) * a.cscale;
      if (__builtin_amdgcn_ballot_w64(mx > m + 8.f) != 0) {
        const float mnew = fmaxf(m, mx);
        const float alpha = __builtin_amdgcn_exp2f(m - mnew);
        m = mnew;
        l *= alpha;
#pragma unroll
        for (int d = 0; d < 4; d++)
#pragma unroll
          for (int i = 0; i < 16; i++) O[d][i] *= alpha;
      }
      float ls = 0.f;
#pragma unroll
      for (int i = 0; i < 16; i++) { const float p0 = __builtin_amdgcn_exp2f(fmaf(S0[i], a.cscale, -m)); S0[i] = p0; ls += p0; }
      u32x4 pp4[4];
#pragma unroll
      for (int sh = 0; sh < 2; sh++) {
        pp4[sh].x = pack2(S0[8 * sh + 0], S0[8 * sh + 1]); pp4[sh].y = pack2(S0[8 * sh + 2], S0[8 * sh + 3]);
        pp4[sh].z = pack2(S0[8 * sh + 4], S0[8 * sh + 5]); pp4[sh].w = pack2(S0[8 * sh + 6], S0[8 * sh + 7]);
      }
      __builtin_amdgcn_s_setprio(1);
      const char* vbase = sV + lr * VST + 8 * hh * 2;
      bf16x8 va[4], vb[4];
#pragma unroll
      for (int dt = 0; dt < 4; dt++) va[dt] = *(const bf16x8_a*)(vbase + dt * 32 * VST);
#pragma unroll
      for (int dt = 0; dt < 4; dt++) vb[dt] = *(const bf16x8_a*)(vbase + dt * 32 * VST + 32);
      __builtin_amdgcn_sched_barrier(0);
      {
        const bf16x8 pf = __builtin_bit_cast(bf16x8, pp4[0]);
#pragma unroll
        for (int dt = 0; dt < 4; dt++) { O[dt] = mfma32(va[dt], pf, O[dt]); va[dt] = *(const bf16x8_a*)(vbase + dt * 32 * VST + 64); }
#pragma unroll
        for (int i = 0; i < 8; i++) { const float p1 = __builtin_amdgcn_exp2f(fmaf(S1[i], a.cscale, -m)); S1[i] = p1; ls += p1; }
        pp4[2].x = pack2(S1[0], S1[1]); pp4[2].y = pack2(S1[2], S1[3]); pp4[2].z = pack2(S1[4], S1[5]); pp4[2].w = pack2(S1[6], S1[7]);
      }
      __builtin_amdgcn_sched_barrier(0);
      {
        const bf16x8 pf = __builtin_bit_cast(bf16x8, pp4[1]);
#pragma unroll
        for (int dt = 0; dt < 4; dt++) { O[dt] = mfma32(vb[dt], pf, O[dt]); vb[dt] = *(const bf16x8_a*)(vbase + dt * 32 * VST + 96); }
#pragma unroll
        for (int i = 8; i < 16; i++) { const float p1 = __builtin_amdgcn_exp2f(fmaf(S1[i], a.cscale, -m)); S1[i] = p1; ls += p1; }
        pp4[3].x = pack2(S1[8], S1[9]); pp4[3].y = pack2(S1[10], S1[11]); pp4[3].z = pack2(S1[12], S1[13]); pp4[3].w = pack2(S1[14], S1[15]);
      }
      l += ls;
      __builtin_amdgcn_sched_barrier(0);
      {
        const bf16x8 pf = __builtin_bit_cast(bf16x8, pp4[2]);
#pragma unroll
        for (int dt = 0; dt < 4; dt++) O[dt] = mfma32(va[dt], pf, O[dt]);
      }
      {
        const bf16x8 pf = __builtin_bit_cast(bf16x8, pp4[3]);
#pragma unroll
        for (int dt = 0; dt < 4; dt++) O[dt] = mfma32(vb[dt], pf, O[dt]);
      }
      __builtin_amdgcn_s_setprio(0);
    }
    if (tl + 1 < ntot) stash(smem + ((tl + 1) & 1) * ATT_BUF);
    __syncthreads();
    if (tl + 2 < ntot) prefetch(tl + 2);
  }
  const float lt = l + shx(l, lane, 32);
  const float linv = 1.f / lt;
  const size_t ro = (size_t)(w * 32 + lr) * 1024;
#pragma unroll
  for (int dt = 0; dt < 4; dt++)
#pragma unroll
    for (int g4 = 0; g4 < 4; g4++) {
      int d = dt * 32 + 8 * g4 + 4 * hh;
      u32x2 gv = *(const u32x2_a*)(a.gate + ro + d);
      float o0 = O[dt][4 * g4 + 0] * linv * bf_lo(gv.x);
      float o1 = O[dt][4 * g4 + 1] * linv * bf_hi(gv.x);
      float o2 = O[dt][4 * g4 + 2] * linv * bf_lo(gv.y);
      float o3 = O[dt][4 * g4 + 3] * linv * bf_hi(gv.y);
      u32x2 ov; ov.x = pack2(o0, o1); ov.y = pack2(o2, o3);
      *(u32x2_a*)(a.out + ro + d) = ov;
    }
}

DI void attnA_any(const Params& P, int l, int it, char* smem) {
  const bool isl = it < 512;
  const int ia = isl ? it : it - 512;
  const int hq = ia & 7, kvh = hq >> 2;
  const int qsb = isl ? ((ia >> 3) & 15) : 0;
  const int b = isl ? (ia >> 7) : (ia >> 3);
  AttnArgs a;
  const size_t tq = isl ? ((size_t)b * 4096 + qsb * 256) : ((size_t)NLAT + b * 256);
  a.Q = P.q_a() + tq * 1024 + hq * 128; a.ldq = 1024;
  a.K1 = P.k_a() + kvh * 128; a.ldk1 = 256; a.K2 = P.k_a();
  int ks = qsb * 256 - 128; if (ks < 0) ks = 0;
  int ke = qsb * 256 + 384; if (ke > 4096) ke = 4096;
  const u16* vctx = P.vTa_ctx() + ((size_t)(b * 2 + kvh) * 128) * 256;
  if (isl) {
    a.seg0_row = b * 4096 + ks; a.seg0_n = ke - ks;
    a.seg0_vT = P.vTa_lat() + ((size_t)(b * 2 + kvh) * 128) * 4096 + ks; a.seg0_ldv = 4096;
    a.seg1_row = NLAT + b * 256; a.seg1_n = 256; a.seg1_vT = vctx; a.seg1_ldv = 256;
    a.qpos0 = qsb * 256; a.kpos0 = ks; a.mask0 = true;
  } else {
    a.seg0_row = NLAT + b * 256; a.seg0_n = 256; a.seg0_vT = vctx; a.seg0_ldv = 256;
    a.seg1_row = 0; a.seg1_n = 0; a.seg1_vT = vctx; a.seg1_ldv = 256;
    a.qpos0 = 0; a.kpos0 = 0; a.mask0 = false;
  }
  a.has_sink = true; a.sink_l2 = P.sink_a[l * 8 + hq] * LOG2E;
  a.cscale = 0.08838834764831845f * LOG2E;
  a.gate = P.saz() + tq * 1024 + hq * 128; a.out = P.ya() + tq * 1024 + hq * 128;
  attn_item<128>(a, smem);
}
DI void attnB_any(const Params& P, int it, char* smem, bool dummy = false) {
  const bool isl = it < 512;
  const int ia = isl ? it : it - 512;
  const int hq = ia & 7;
  const int qsb = isl ? ((ia >> 3) & 15) : 0;
  const int b = isl ? (ia >> 7) : (ia >> 3);
  AttnArgs a;
  const size_t tq = isl ? ((size_t)b * 4096 + qsb * 256) : ((size_t)NLAT + b * 256);
  a.Q = P.q_b() + tq * 1536 + hq * 192; a.ldq = 1536;
  a.K1 = P.kn_b() + hq * 128; a.ldk1 = 1024; a.K2 = P.kr();
  const u16* vctx = P.vTb_ctx() + ((size_t)(b * 8 + hq) * 128) * 256;
  if (isl) {
    a.seg0_row = b * 4096; a.seg0_n = 4096;
    a.seg0_vT = P.vTb_lat() + ((size_t)(b * 8 + hq) * 128) * 4096; a.seg0_ldv = 4096;
    a.seg1_row = NLAT + b * 256; a.seg1_n = 256; a.seg1_vT = vctx; a.seg1_ldv = 256;
  } else {
    a.seg0_row = NLAT + b * 256; a.seg0_n = 256; a.seg0_vT = vctx; a.seg0_ldv = 256;
    a.seg1_row = 0; a.seg1_n = 0; a.seg1_vT = vctx; a.seg1_ldv = 256;
  }
  a.qpos0 = 0; a.kpos0 = 0; a.mask0 = false;
  a.has_sink = false; a.sink_l2 = 0.f;
  a.cscale = 0.07216878364870322f * LOG2E;
  a.gate = P.sbz() + tq * 1024 + hq * 128; a.out = (dummy ? P.h() : P.yb()) + tq * 1024 + hq * 128;
  attn_item<192>(a, smem);
}

constexpr int SGU_ST = 272;
DI void sgu_item(const Params& P, int l, int ch, int g, char* smem) {
  const int tid = otid() & 255, lane = tid & 63, w = tid >> 6, wr = w >> 1, wc = w & 1, lr = lane & 31, hh = lane >> 5;
  float* st = (float*)(smem + 2 * 128 * SGU_ST);
  if (tid < 128) {
    const float* sp = P.cvst() + (size_t)(ch * 128 + tid) * 32;
    float s1 = 0.f, s2 = 0.f;
#pragma unroll
    for (int j = 0; j < 16; j++) { s1 += sp[2 * j]; s2 += sp[2 * j + 1]; }
    float mu = s1 * (1.f / 1024.f);
    float var = s2 * (1.f / 1024.f) - mu * mu;
    st[tid * 2] = mu; st[tid * 2 + 1] = rsqrtf(fmaxf(var, 0.f) + EPS);
  }
  __syncthreads();
  char* sA = smem; char* sB = smem + 128 * SGU_ST;
  const u16* Ag = P.SguW() + (size_t)(l * 8 + g) * 128 * 128;
  const u16* Bg = P.cvT() + ((size_t)ch * 1024 + g * 128) * 128;
#pragma unroll
  for (int i = 0; i < 8; i++) {
    int id = tid + 256 * i, r = id >> 4, cc = id & 15;
    st16(sA + r * SGU_ST + cc * 16, ld16(Ag + r * 128 + cc * 8));
    float v[8]; unpack8(ld16(Bg + r * 128 + cc * 8), v);
    float gam = P.sgu_ln_g[l * 1024 + g * 128 + r], bet = P.sgu_ln_b[l * 1024 + g * 128 + r];
#pragma unroll
    for (int e = 0; e < 8; e++) {
      int q = cc * 8 + e;
      v[e] = (v[e] - st[2 * q]) * st[2 * q + 1] * gam + bet;
    }
    st16(sB + r * SGU_ST + cc * 16, pack8(v));
  }
  __syncthreads();
  f32x16 acc[2][2]; zero_acc(acc);
  {
    const char* pa = sA + (wr * 64 + lr) * SGU_ST + hh * 16;
    const char* pb = sB + (wc * 64 + lr) * SGU_ST + hh * 16;
#pragma unroll
    for (int s = 0; s < 8; s++) {
      bf16x8 a0 = *(const bf16x8_a*)(pa + s * 32);
      bf16x8 a1 = *(const bf16x8_a*)(pa + 32 * SGU_ST + s * 32);
      bf16x8 b0 = *(const bf16x8_a*)(pb + s * 32);
      bf16x8 b1 = *(const bf16x8_a*)(pb + 32 * SGU_ST + s * 32);
      acc[0][0] = mfma32(a0, b0, acc[0][0]);
      acc[0][1] = mfma32(a0, b1, acc[0][1]);
      acc[1][0] = mfma32(a1, b0, acc[1][0]);
      acc[1][1] = mfma32(a1, b1, acc[1][1]);
    }
  }
  __syncthreads();
  float* stg = (float*)smem;
  stage_acc(acc, stg, tid);
  __syncthreads();
#pragma unroll
  for (int j = 0; j < 8; j++) {
    int id = tid + 256 * j, r = id >> 4, c8 = (id & 15) * 8;
    float v[8]; ldstg8(stg, r, c8, v);
    const size_t off = (size_t)(ch * 128 + r) * 1024 + g * 128 + c8;
    float u[8], z[8];
    unpack8(ld16(P.cu() + off), u); unpack8(ld16(P.scz() + off), z);
    float bs = P.sgu_b[(l * 8 + g) * 128 + r];
#pragma unroll
    for (int e = 0; e < 8; e++) v[e] = u[e] * (v[e] + bs) * z[e];
    st16(P.yc() + off, pack8(v));
  }
  __syncthreads();
}


DI void phase_g1(const Params& P, int l, int bid, int nb, char* smem) {
  OrderG1 S{nb, bid, l};
  EpiG1 E{P};
  pg8::gemm_phase(( PG8_LAS unsigned char*)smem, P.h(), P.WinT(), 2048, S, E);
}
DI void phase_g2(const Params& P, int l, int bid, int nb, char* smem) {
  const int half = otid() >> 8;
  char* hs = smem + half * HALF_SMEM;
  const int na = (l == 0) ? 544 : 512;
  for (int it = bid; it < na; it += nb) attnA_any(P, l, it, smem);
  {
    OrderG2 S{nb, bid, l};
    EpiG2 E{P};
    pg8::gemm_phase((PG8_LAS unsigned char*)smem, P.cq(), P.WuqT(), 512, S, E);
  }
  const int nch = (l == 0) ? 136 : 128;
  for (int it2 = bid; it2 * 2 < nch * 8; it2 += nb) { const int it = it2 * 2 + half; sgu_item(P, l, it >> 3, it & 7, hs); }
}
DI void phase_attb(const Params& P, int l, int bid, int nb, char* smem) {
  const int half = otid() >> 8;
  char* hs = smem + half * HALF_SMEM;
  const int na = (l == 0) ? 544 : 512;
#if MK_DUP & 2
  for (int it = bid; it < na; it += nb) attnB_any(P, it, smem, true);
#endif
  for (int it = bid; it < na; it += nb) attnB_any(P, it, smem);
}
DI void phase_g3(const Params& P, int l, int bid, int nb, char* smem) {
  OrderG3 S{nb, bid, (l == 0) ? 68 : 64};
  EpiG3 E{P};
  pg8::gemm_phase((PG8_LAS unsigned char*)smem, P.ya(), P.WpT(), 1024, S, E);
}
DI void phase_g4(const Params& P, int l, int bid, int nb, char* smem) {
  pg8::GridOrder S; S.init((l == 0) ? 68 : 64, 8, nb, bid);
  EpiG4 E{P, l};
  pg8::gemm_phase((PG8_LAS unsigned char*)smem, P.m(), P.WoutT(), 2048, S, E);
}

DI void run_phase(const Params& P, int ph, int bid, int nb, char* smem) {
  if (ph == 0) { phase_w(P, 0, bid, nb, smem); return; }
  if (ph == 13) { phase_final(P, bid, nb); return; }
  const int l = (ph - 1) / 6, s = (ph - 1) % 6;
  switch (s) {
    case 0: phase_norm(P, l, bid, nb); if (l == 1) phase_w(P, 1, bid, nb, smem); break;
    case 1: phase_g1(P, l, bid, nb, smem); break;
    case 2: phase_g2(P, l, bid, nb, smem); break;
    case 3: phase_attb(P, l, bid, nb, smem); break;
    case 4: phase_g3(P, l, bid, nb, smem); break;
    default: phase_g4(P, l, bid, nb, smem); break;
  }
}

extern __shared__ __attribute__((aligned(16))) char dyn_smem[];

DI void fast_grid_sync(unsigned* bar, unsigned k, unsigned nb) {
  asm volatile("s_waitcnt vmcnt(0)" ::: "memory");
  __syncthreads();
  if (threadIdx.x == 0) {
    __builtin_amdgcn_fence(__ATOMIC_RELEASE, "agent");
    asm volatile("s_waitcnt vmcnt(0)" ::: "memory");
    const unsigned g = blockIdx.x >> 4;
    const unsigned ngroups = (nb + 15u) >> 4;
    const unsigned gsz = (g + 1u == ngroups) ? nb - g * 16u : 16u;
    unsigned* rel = bar + 32 * 17;
    const unsigned old = __hip_atomic_fetch_add(bar + 32 * g, 1u, __ATOMIC_RELAXED, __HIP_MEMORY_SCOPE_AGENT);
    if (old + 1u == k * gsz) {
      const unsigned t = __hip_atomic_fetch_add(bar + 32 * 16, 1u, __ATOMIC_RELAXED, __HIP_MEMORY_SCOPE_AGENT);
      if (t + 1u == k * ngroups) __hip_atomic_store(rel, k, __ATOMIC_RELAXED, __HIP_MEMORY_SCOPE_AGENT);
    }
    while (__hip_atomic_load(rel, __ATOMIC_RELAXED, __HIP_MEMORY_SCOPE_AGENT) < k) __builtin_amdgcn_s_sleep(1);
    __builtin_amdgcn_fence(__ATOMIC_ACQUIRE, "agent");
    asm volatile("s_waitcnt vmcnt(0)" ::: "memory");
  }
  __syncthreads();
}

#if MK_MULTI
__global__ void __launch_bounds__(NTHR, 2) k_phase(Params P, int ph) {
  run_phase(P, ph, blockIdx.x, gridDim.x, dyn_smem);
}
#endif

#if !MK_MULTI
__global__ void __launch_bounds__(NTHR, 2) k_mega(Params P) {
  const int bid = blockIdx.x, nb = gridDim.x;
  unsigned* ctr = (unsigned*)(P.ws + WS_BAR);
  unsigned nsync = 0;
#define GSYNC() do { nsync += 1u; fast_grid_sync(ctr, nsync, (unsigned)nb); } while (0)
  phase_w(P, 0, bid, nb, dyn_smem);
  if (nb < 0) cg::this_grid().sync();
  GSYNC();
#pragma unroll 1
  for (int l = 0; l < 2; l++) {
    phase_norm(P, l, bid, nb);
    if (l == 1) phase_w(P, 1, bid, nb, dyn_smem);
    GSYNC();
#if MK_DUP & 1
    phase_g1(P, l, bid, nb, dyn_smem); GSYNC();
#endif
    phase_g1(P, l, bid, nb, dyn_smem); GSYNC();
    phase_g2(P, l, bid, nb, dyn_smem); GSYNC();
    phase_attb(P, l, bid, nb, dyn_smem); GSYNC();
#if MK_DUP & 4
    phase_g3(P, l, bid, nb, dyn_smem); GSYNC();
#endif
    phase_g3(P, l, bid, nb, dyn_smem); GSYNC();
    phase_g4(P, l, bid, nb, dyn_smem); GSYNC();
  }
  phase_final(P, bid, nb);
#undef GSYNC
}
#endif

__global__ void k_fill(float* o, int n, float v) { int i = blockIdx.x * 256 + threadIdx.x; if (i < n) o[i] = v; }

extern "C" void kernel_launch(void* const* d_in, const int* in_sizes, int n_in, void* d_out, int out_size, void* d_ws,
                              size_t ws_size, hipStream_t stream) {
  static int grid_blocks = 0;
  if (!grid_blocks) {
    int dev = 0, cus = 0, per_cu = 0;
    hipGetDevice(&dev);
    hipDeviceGetAttribute(&cus, hipDeviceAttributeMultiprocessorCount, dev);
#if MK_MULTI
    const void* kfn = (const void*)k_phase;
#else
    const void* kfn = (const void*)k_mega;
#endif
    hipFuncSetAttribute(kfn, hipFuncAttributeMaxDynamicSharedMemorySize, SMEM_BYTES);
    hipOccupancyMaxActiveBlocksPerMultiprocessor(&per_cu, kfn, NTHR, SMEM_BYTES);
    if (per_cu < 1) per_cu = 1;
    grid_blocks = cus;
    (void)hipGetLastError();
  }
  Params P{};
  const float** ins = (const float**)&P;
  for (int i = 0; i < 22; i++) ins[i] = (const float*)d_in[i];
  P.out = (float*)d_out;
  P.ws = (char*)d_ws;
  if (WS_TOTAL > ws_size || grid_blocks > 256) {
    fprintf(stderr, "workspace too small or unexpected grid\n");
    hipLaunchKernelGGL(k_fill, dim3((out_size + 255) / 256), dim3(256), 0, stream, (float*)d_out, out_size, 7777.f);
    return;
  }
#if MK_MULTI
  for (int ph = 0; ph < 14; ph++) hipLaunchKernelGGL(k_phase, dim3(grid_blocks), dim3(NTHR), SMEM_BYTES, stream, P, ph);
#else
  hipMemsetAsync((char*)d_ws + WS_BAR, 0, 4096, stream);
  void* args[] = {&P};
  hipError_t e = hipLaunchCooperativeKernel((const void*)k_mega, dim3(grid_blocks), dim3(NTHR), args, SMEM_BYTES, stream);
  if (e != hipSuccess) fprintf(stderr, "cooperative launch failed: %s (grid %d)\n", hipGetErrorString(e), grid_blocks);
#endif
}
```

```cpp
#include <hip/hip_runtime.h>
#include <hip/hip_cooperative_groups.h>
#include <cstdio>
namespace cg = cooperative_groups;

#ifndef MK_MULTI
#define MK_MULTI 0
#endif
#ifndef MK_DUP
#define MK_DUP 0
#endif

typedef unsigned short u16;
typedef __attribute__((ext_vector_type(8))) short bf16x8;
typedef __attribute__((ext_vector_type(4))) short s16x4;
typedef __attribute__((ext_vector_type(16))) float f32x16;
typedef __attribute__((ext_vector_type(4))) float f32x4;
typedef __attribute__((ext_vector_type(4))) unsigned u32x4;
typedef __attribute__((ext_vector_type(2))) unsigned u32x2;
typedef u32x4 __attribute__((may_alias)) u32x4_a;
typedef u32x2 __attribute__((may_alias)) u32x2_a;
typedef f32x4 __attribute__((may_alias)) f32x4_a;
typedef bf16x8 __attribute__((may_alias)) bf16x8_a;
typedef s16x4 __attribute__((may_alias)) s16x4_a;

#define DI __device__ __forceinline__

constexpr int T_TOK = 17408, NLAT = 16384, DM = 2048;
constexpr int NIN = 14080;
constexpr float EPS = 1e-6f;
constexpr float LOG2E = 1.4426950408889634f;

constexpr int NTHR = 512;
constexpr int CST = 132;
constexpr int HALF_SMEM = 70656;
constexpr int SMEM_BYTES = 2 * HALF_SMEM;

struct Params {
  const float *x, *c, *ctx, *c_ctx, *ada_w, *ada_b, *norm_g, *w_in, *sink_a, *mla_gq, *mla_gkv, *w_uq, *w_ukv,
      *sgu_ln_g, *sgu_ln_b, *sgu_w, *sgu_b, *w_pa, *w_pb, *w_pc, *w_out, *final_g;
  float* out;
  char* ws;
  DI u16* WinT() const { return (u16*)(ws + 0ull); }
  DI u16* WuqT() const { return (u16*)(ws + 57671680ull); }
  DI u16* WukvT() const { return (u16*)(ws + 59244544ull); }
  DI u16* WpT() const { return (u16*)(ws + 61341696ull); }
  DI u16* WoutT() const { return (u16*)(ws + 73924608ull); }
  DI u16* SguW() const { return (u16*)(ws + 82313216ull); }
  DI u16* h() const { return (u16*)(ws + 83107840ull); }
  DI u16* q_a() const { return (u16*)(ws + 738795520ull); }
  DI u16* k_a() const { return (u16*)(ws + 510926848ull); }
  DI u16* vTa_lat() const { return (u16*)(ws + 519839744ull); }
  DI u16* vTa_ctx() const { return (u16*)(ws + 528228352ull); }
  DI u16* saz() const { return (u16*)(ws + 154411008ull); }
  DI u16* cq() const { return (u16*)(ws + 261365760ull); }
  DI u16* ckv() const { return (u16*)(ws + 279191552ull); }
  DI u16* sbz() const { return (u16*)(ws + 190062592ull); }
  DI u16* cu() const { return (u16*)(ws + 528752640ull); }
  DI u16* cvT() const { return (u16*)(ws + 564404224ull); }
  DI u16* scz() const { return (u16*)(ws + 225714176ull); }
  DI u16* sg() const { return (u16*)(ws + 297017344ull); }
  DI u16* kr() const { return (u16*)(ws + 600055808ull); }
  DI u16* q_b() const { return (u16*)(ws + 614014976ull); }
  DI u16* kn_b() const { return (u16*)(ws + 667492352ull); }
  DI u16* vTb_lat() const { return (u16*)(ws + 703143936ull); }
  DI u16* vTb_ctx() const { return (u16*)(ws + 736698368ull); }
  DI u16* ya() const { return (u16*)(ws + 154411008ull); }
  DI u16* yb() const { return (u16*)(ws + 190062592ull); }
  DI u16* yc() const { return (u16*)(ws + 225714176ull); }
  DI u16* m() const { return (u16*)(ws + 614014976ull); }
  DI float* mod() const { return (float*)(ws + 82837504ull); }
  DI float* tab32() const { return (float*)(ws + 83083264ull); }
  DI float* tab16() const { return (float*)(ws + 83099648ull); }
  DI float* ssq_q() const { return (float*)(ws + 602284032ull); }
  DI float* ssq_kv() const { return (float*)(ws + 602841088ull); }
  DI float* cvst() const { return (float*)(ws + 603398144ull); }
  DI float* xres() const { return (float*)(ws + 605626368ull); }
  DI float* gscr() const { return (float*)(ws + 685318144ull); }
};
constexpr size_t WS_BAR = 774447104ull;
constexpr size_t WS_TOTAL = 774451200ull;

DI u16 f2bf(float x) { unsigned u = __float_as_uint(x); u += 0x7fffu + ((u >> 16) & 1u); return (u16)(u >> 16); }
typedef __attribute__((ext_vector_type(2))) float f32x2_t;
typedef __attribute__((ext_vector_type(2))) __bf16 bf16x2_t;
DI unsigned pack2(float a, float b) { f32x2_t v = {a, b}; return __builtin_bit_cast(unsigned, __builtin_convertvector(v, bf16x2_t)); }
DI float bf_lo(unsigned v) { return __uint_as_float(v << 16); }
DI float bf_hi(unsigned v) { return __uint_as_float(v & 0xffff0000u); }
DI u32x4 ld16(const void* p) { return *(const u32x4_a*)p; }
DI void st16(void* p, u32x4 v) { *(u32x4_a*)p = v; }
DI f32x16 mfma32(bf16x8 a, bf16x8 b, f32x16 c) { return __builtin_amdgcn_mfma_f32_32x32x16_bf16(a, b, c, 0, 0, 0); }
DI float siluf(float v) { return v * __builtin_amdgcn_rcpf(1.f + __expf(-v)); }
DI float sigmf(float v) { return __builtin_amdgcn_rcpf(1.f + __expf(-v)); }
DI int otid() { int t = threadIdx.x; asm volatile("" : "+v"(t)); return t; }
DI float shx(float v, int lane, int o) { return __int_as_float(__builtin_amdgcn_ds_bpermute((lane ^ o) << 2, __float_as_int(v))); }
DI int vperm(int t) { return (t & ~15) | (t & 3) | (((t >> 2) & 1) << 3) | (((t >> 3) & 1) << 2); }
DI float max3f(float a, float b, float c) { float r; asm("v_max3_f32 %0, %1, %2, %3" : "=v"(r) : "v"(a), "v"(b), "v"(c)); return r; }
DI int crow(int i, int hh) { return (i & 3) + 8 * (i >> 2) + 4 * hh; }
DI void unpack8(u32x4 v, float (&f)[8]) {
  f[0] = bf_lo(v.x); f[1] = bf_hi(v.x); f[2] = bf_lo(v.y); f[3] = bf_hi(v.y);
  f[4] = bf_lo(v.z); f[5] = bf_hi(v.z); f[6] = bf_lo(v.w); f[7] = bf_hi(v.w);
}
DI u32x4 pack8(const float (&f)[8]) {
  u32x4 r; r.x = pack2(f[0], f[1]); r.y = pack2(f[2], f[3]); r.z = pack2(f[4], f[5]); r.w = pack2(f[6], f[7]); return r;
}
DI void ldstg8(const float* stg, int r, int c8, float (&v)[8]) {
  f32x4 a = *(const f32x4_a*)(stg + r * CST + c8), b = *(const f32x4_a*)(stg + r * CST + c8 + 4);
  v[0] = a.x; v[1] = a.y; v[2] = a.z; v[3] = a.w; v[4] = b.x; v[5] = b.y; v[6] = b.z; v[7] = b.w;
}
DI void zero_acc(f32x16 (&acc)[2][2]) {
#pragma unroll
  for (int a = 0; a < 2; a++)
#pragma unroll
    for (int b = 0; b < 2; b++)
#pragma unroll
      for (int i = 0; i < 16; i++) acc[a][b][i] = 0.f;
}
DI void stage_acc(const f32x16 (&acc)[2][2], float* stg, int tid) {
  const int lane = tid & 63, w = tid >> 6, wr = w >> 1, wc = w & 1, lr = lane & 31, hh = lane >> 5;
#pragma unroll
  for (int ta = 0; ta < 2; ta++)
#pragma unroll
    for (int tb = 0; tb < 2; tb++)
#pragma unroll
      for (int i = 0; i < 16; i++) {
        int row = wr * 64 + ta * 32 + crow(i, hh), col = wc * 64 + tb * 32 + lr;
        stg[row * CST + col] = acc[ta][tb][i];
      }
}

#define PG8_LAS __attribute__((address_space(3)))
namespace pg8 {
constexpr int BM = 256, BK = 64, HALF = 128, HTB = HALF * BK * 2, STAGE_BYTES = 8 * HTB, NXCD = 8, WGM = 8;
DI int lds_byte(int r, int c) { const int st = (r >> 4) * 2 + (c >> 5), rr = r & 15, cc = c & 31, ob = rr * 64 + cc * 2; return st * 1024 + (ob ^ (((ob >> 9) & 1) << 5)); }
DI void stage_rc(int b, int& R, int& C) { const int st = b / 1024, sb = b % 1024, swz = sb ^ (((sb >> 9) & 1) << 5); R = (st >> 1) * 16 + swz / 64; C = (st & 1) * 32 + (swz % 64) / 2; }
DI int perm32(int rho) { const int n = rho >> 4, i = rho & 15; return 8 * (i >> 2) + 4 * n + (i & 3); }
struct Unit { int pm, pn; };

template <class Epi, class Sched>
DI void gemm_phase(PG8_LAS unsigned char* lds, const u16* Abase, const u16* Btbase, const int K, const Sched& S, const Epi& E) {
    const int tid = otid(), wid = __builtin_amdgcn_readfirstlane(tid >> 6), lane = tid & 63, wr = wid >> 2, wc = wid & 3, fr = lane & 15, fq = lane >> 4;
    const int nt = K / BK;
    unsigned voffA[2], voffB[2];
#pragma unroll
    for (int i = 0; i < 2; ++i) { int R, C; stage_rc(tid * 16 + i * 8192, R, C); const int Rb = (R & ~31) + perm32(R & 31);
        voffA[i] = (unsigned)(R * K + C) * 2u; voffB[i] = (unsigned)(Rb * K + C) * 2u; }
    const size_t kstep = (size_t)(BK * 2);
    const size_t hstep = (size_t)HALF * K * 2;
    const size_t tstep = 2 * hstep;
    const unsigned ldsw = (unsigned)wid * 1024u;
    const int aoff = lds_byte(wr * 64 + fr, fq * 8), boff = lds_byte(wc * 32 + fr, fq * 8);
#define PG8_SA(b, h) (((b) * 2 + (h)) * HTB)
#define PG8_SB(b, h) ((4 + (b) * 2 + (h)) * HTB)
#define PG8_STAGE(bufoff, gbase, voff) do { _Pragma("unroll") for (int _i = 0; _i < 2; ++_i) \
        __builtin_amdgcn_global_load_lds((const unsigned*)((const char*)(gbase) + (voff)[_i]), (PG8_LAS unsigned*)(lds + (bufoff) + ldsw + _i * 8192), 16, 0, 0); } while (0)
#define PG8_LDA(dst, b, h) do { _Pragma("unroll") for (int m = 0; m < 4; ++m) _Pragma("unroll") for (int k = 0; k < 2; ++k) dst[m][k] = *(const PG8_LAS bf16x8*)(lds + PG8_SA(b, h) + aoff + m * 2048 + k * 1024); } while (0)
#define PG8_LDB(dst, b, h) do { _Pragma("unroll") for (int n = 0; n < 2; ++n) _Pragma("unroll") for (int k = 0; k < 2; ++k) dst[n][k] = *(const PG8_LAS bf16x8*)(lds + PG8_SB(b, h) + boff + n * 2048 + k * 1024); } while (0)
#define PG8_MMA(ai, bj, At, Bt) do { __builtin_amdgcn_s_setprio(1); _Pragma("unroll") for (int m = 0; m < 4; ++m) _Pragma("unroll") for (int n = 0; n < 2; ++n) _Pragma("unroll") for (int k = 0; k < 2; ++k) \
        acc[ai][bj][m][n] = __builtin_amdgcn_mfma_f32_16x16x32_bf16(Bt[n][k], At[m][k], acc[ai][bj][m][n], 0, 0, 0); __builtin_amdgcn_s_setprio(0); } while (0)
#define PG8_WAIT_V(n) asm volatile("s_waitcnt vmcnt(" #n ")" ::: "memory")
#define PG8_WAIT_L(n) asm volatile("s_waitcnt lgkmcnt(" #n ")" ::: "memory")
#define PG8_BAR __builtin_amdgcn_s_barrier()
#define PG8_SCHED __builtin_amdgcn_sched_barrier(0)
    Unit cur, nxt; int ui = 0;
    if (!S.next(0, cur)) return;
    f32x4 acc[2][2][4][2];
#pragma unroll
    for (int a = 0; a < 2; ++a)
#pragma unroll
        for (int b = 0; b < 2; ++b)
#pragma unroll
            for (int m = 0; m < 4; ++m)
#pragma unroll
                for (int n = 0; n < 2; ++n) acc[a][b][m][n] = (f32x4){0.f, 0.f, 0.f, 0.f};
    bf16x8 At[4][2], B0[2][2], B1[2][2];
    const char* cA = (const char*)Abase + (size_t)cur.pm * tstep; const char* cB = (const char*)Btbase + (size_t)cur.pn * tstep;
    PG8_STAGE(PG8_SB(0, 0), cB, voffB); PG8_STAGE(PG8_SA(0, 0), cA, voffA); PG8_STAGE(PG8_SB(0, 1), cB + hstep, voffB); PG8_STAGE(PG8_SA(0, 1), cA + hstep, voffA);
    if (wr == 1) PG8_BAR;
    PG8_WAIT_V(4); PG8_BAR;
    PG8_STAGE(PG8_SB(1, 0), cB + kstep, voffB); PG8_STAGE(PG8_SA(1, 0), cA + kstep, voffA); PG8_STAGE(PG8_SB(1, 1), cB + hstep + kstep, voffB);
    PG8_WAIT_V(6); PG8_BAR;
    for (;;) {
        const bool has_next = S.next(ui + 1, nxt);
        const char* nA = has_next ? (const char*)Abase + (size_t)nxt.pm * tstep : cA; const char* nB = has_next ? (const char*)Btbase + (size_t)nxt.pn * tstep : cB;
        for (int t = 0; t < nt; t += 2) {
            const bool last = (t == nt - 2);
            const char* a1 = cA + (size_t)(t + 1) * kstep;
            const char* a2 = last ? nA : cA + (size_t)(t + 2) * kstep; const char* b2 = last ? nB : cB + (size_t)(t + 2) * kstep;
            const char* a3 = a2 + kstep; const char* b3 = b2 + kstep;
            PG8_LDB(B0, 0, 0); PG8_SCHED; PG8_LDA(At, 0, 0); PG8_STAGE(PG8_SA(1, 1), a1 + hstep, voffA);
            PG8_WAIT_L(8); PG8_BAR; PG8_WAIT_L(0); PG8_MMA(0, 0, At, B0); PG8_BAR; PG8_SCHED;
            PG8_LDB(B1, 0, 1); PG8_STAGE(PG8_SB(0, 0), b2, voffB);
            PG8_BAR; PG8_WAIT_L(0); PG8_MMA(0, 1, At, B1); PG8_BAR;
            PG8_LDA(At, 0, 1); PG8_STAGE(PG8_SA(0, 0), a2, voffA);
            PG8_BAR; PG8_WAIT_L(0); PG8_MMA(1, 0, At, B0); PG8_BAR; PG8_SCHED;
            PG8_STAGE(PG8_SB(0, 1), b2 + hstep, voffB);
            PG8_WAIT_V(6); PG8_BAR; PG8_MMA(1, 1, At, B1); PG8_BAR;
            PG8_LDB(B0, 1, 0); PG8_SCHED; PG8_LDA(At, 1, 0); PG8_STAGE(PG8_SA(0, 1), a2 + hstep, voffA);
            PG8_WAIT_L(8); PG8_BAR; PG8_WAIT_L(0); PG8_MMA(0, 0, At, B0); PG8_BAR; PG8_SCHED;
            PG8_LDB(B1, 1, 1); PG8_STAGE(PG8_SB(1, 0), b3, voffB);
            PG8_BAR; PG8_WAIT_L(0); PG8_MMA(0, 1, At, B1); PG8_BAR;
            PG8_LDA(At, 1, 1); PG8_STAGE(PG8_SA(1, 0), a3, voffA);
            PG8_BAR; PG8_WAIT_L(0); PG8_MMA(1, 0, At, B0); PG8_BAR; PG8_SCHED;
            PG8_STAGE(PG8_SB(1, 1), b3 + hstep, voffB);
            PG8_WAIT_V(6); PG8_BAR; PG8_MMA(1, 1, At, B1); PG8_BAR;
        }
        bool keep = false;
        if constexpr (Epi::CHAIN) keep = E(acc, cur, wr, wc, fr, fq); else E(acc, cur, wr, wc, fr, fq);
        if (!has_next) break;
        if (!keep) {
#pragma unroll
        for (int a = 0; a < 2; ++a)
#pragma unroll
            for (int b = 0; b < 2; ++b)
#pragma unroll
                for (int m = 0; m < 4; ++m)
#pragma unroll
                    for (int n = 0; n < 2; ++n) acc[a][b][m][n] = (f32x4){0.f, 0.f, 0.f, 0.f};
        }
        cur = nxt; cA = nA; cB = nB; ++ui;
    }
    PG8_WAIT_V(0);
    if (wr == 0) PG8_BAR;
    PG8_BAR;
#undef PG8_SA
#undef PG8_SB
#undef PG8_STAGE
#undef PG8_LDA
#undef PG8_LDB
#undef PG8_MMA
#undef PG8_WAIT_V
#undef PG8_WAIT_L
#undef PG8_BAR
#undef PG8_SCHED
}

DI void grid_map(int L, int nM, int nN, int& pm, int& pn) {
    const int nwg = nM * nN;
    int wgid = L; { const int q = nwg / NXCD, r = nwg % NXCD, xcd = wgid % NXCD, off = wgid / NXCD; wgid = (xcd < r ? xcd * (q + 1) : r * (q + 1) + (xcd - r) * q) + off; }
    const int nig = WGM * nN, gid = wgid / nig, fm = gid * WGM, gsz = (nM - fm) < WGM ? (nM - fm) : WGM;
    pm = fm + ((wgid % nig) % gsz); pn = (wgid % nig) / gsz;
}
struct GridOrder {
    int nM, nN, nwg, G, c;
    DI void init(int nM_, int nN_, int G_, int c_) { nM = nM_; nN = nN_; nwg = nM * nN; G = G_; c = c_; }
    DI bool next(int i, Unit& u) const {
        const int L = i * G + c; if (L >= nwg) return false;
        int wgid = L; { const int q = nwg / NXCD, r = nwg % NXCD, xcd = wgid % NXCD, off = wgid / NXCD; wgid = (xcd < r ? xcd * (q + 1) : r * (q + 1) + (xcd - r) * q) + off; }
        const int nig = WGM * nN, gid = wgid / nig, fm = gid * WGM, gsz = (nM - fm) < WGM ? (nM - fm) : WGM;
        u.pm = fm + ((wgid % nig) % gsz); u.pn = (wgid % nig) / gsz; return true;
    }
};
}

DI void acc8(const f32x4 (&acc)[2][2][4][2], int ai, int bj, int m, float (&v)[8]) {
  f32x4 a = acc[ai][bj][m][0], b = acc[ai][bj][m][1];
  v[0] = a.x; v[1] = a.y; v[2] = a.z; v[3] = a.w; v[4] = b.x; v[5] = b.y; v[6] = b.z; v[7] = b.w;
}
DI void rope8v(float (&v)[8], f32x4 t0, f32x4 t1) {
  float a, b;
  a = v[0]; b = v[1]; v[0] = a * t0.x - b * t0.y; v[1] = a * t0.y + b * t0.x;
  a = v[2]; b = v[3]; v[2] = a * t0.z - b * t0.w; v[3] = a * t0.w + b * t0.z;
  a = v[4]; b = v[5]; v[4] = a * t1.x - b * t1.y; v[5] = a * t1.y + b * t1.x;
  a = v[6]; b = v[7]; v[6] = a * t1.z - b * t1.w; v[7] = a * t1.w + b * t1.z;
}

DI void rope8(float (&v)[8], const float* tb) { rope8v(v, *(const f32x4_a*)tb, *(const f32x4_a*)(tb + 4)); }

template <int KIND>
DI void g1_body(const Params& P, const f32x4 (&acc)[2][2][4][2], const pg8::Unit& u, int wr, int wc, int fr, int fq,
                u16* dbase, int ldo, int coff, float* sbase) {
  const int lane = otid() & 63;
  const bool lat = u.pm < 64;
  f32x4 rt[2][4][2];
  if ((KIND == 0 || KIND == 1 || KIND == 7) && lat) {
    const int o = 32 * wc + 8 * fq;
    const int axis = (KIND == 7) ? ((o & 63) >> 5) : (o >> 6);
    const int i0 = (KIND == 7) ? ((o & 31) >> 1) : ((o & 63) >> 1);
    const float* tbase = (KIND == 7) ? P.tab16() : P.tab32();
    const int half = (KIND == 7) ? 16 : 32;
#pragma unroll
    for (int ai = 0; ai < 2; ai++)
#pragma unroll
      for (int m = 0; m < 4; m++) {
        const int pos = (u.pm * 256 + ai * 128 + wr * 64 + m * 16 + fr) & 4095;
        const int p = axis ? (pos & 63) : (pos >> 6);
        const float* tb = tbase + (size_t)(p * half + i0) * 2;
        rt[ai][m][0] = *(const f32x4_a*)tb; rt[ai][m][1] = *(const f32x4_a*)(tb + 4);
      }
    __builtin_amdgcn_sched_barrier(0);
  }
#pragma unroll
  for (int ai = 0; ai < 2; ai++) {
#pragma unroll
    for (int m = 0; m < 4; m++) {
      const int tok = u.pm * 256 + ai * 128 + wr * 64 + m * 16 + fr;
      const int pos = tok & 4095;
      const int b = lat ? (tok >> 12) : ((tok - NLAT) >> 8);
      float s1 = 0.f, s2 = 0.f;
#pragma unroll
      for (int bj = 0; bj < 2; bj++) {
        float v[8]; acc8(acc, ai, bj, m, v);
        const int o = 32 * wc + 8 * fq;
        const int c0 = 128 * bj + o;
        if (KIND == 0 || KIND == 1) {
          if (lat) rope8v(v, rt[ai][m][0], rt[ai][m][1]);
          st16(dbase + (size_t)tok * ldo + coff + c0, pack8(v));
        } else if (KIND == 2) {
          u16* dst = lat ? P.vTa_lat() + ((size_t)(b * 2 + bj) * 128 + o) * 4096 + vperm(pos)
                         : P.vTa_ctx() + ((size_t)(b * 2 + bj) * 128 + o) * 256 + vperm((tok - NLAT) & 255);
          const size_t ld = lat ? 4096 : 256;
#pragma unroll
          for (int j = 0; j < 4; j++) { const unsigned pw = pack2(v[2 * j], v[2 * j + 1]); dst[(2 * j) * ld] = (u16)pw; dst[(2 * j + 1) * ld] = (u16)(pw >> 16); }
        } else if (KIND == 3) {
#pragma unroll
          for (int j = 0; j < 8; j++) v[j] = siluf(v[j]);
          st16(dbase + (size_t)tok * ldo + coff + c0, pack8(v));
        } else if (KIND == 4) {
          st16(dbase + (size_t)tok * ldo + coff + c0, pack8(v));
#pragma unroll
          for (int j = 0; j < 8; j++) s2 += v[j] * v[j];
        } else if (KIND == 5) {
          st16(dbase + (size_t)tok * ldo + coff + c0, pack8(v));
        } else if (KIND == 6) {
          u16* dst = P.cvT() + ((size_t)(tok >> 7) * 1024 + coff + c0) * 128 + (tok & 127);
#pragma unroll
          for (int j = 0; j < 4; j++) { const unsigned pw = pack2(v[2 * j], v[2 * j + 1]); dst[(2 * j) * 128] = (u16)pw; dst[(2 * j + 1) * 128] = (u16)(pw >> 16); }
#pragma unroll
          for (int j = 0; j < 8; j++) { s1 += v[j]; s2 += v[j] * v[j]; }
        } else if (KIND == 7) {
          if (c0 < 64) {
            if (lat) rope8v(v, rt[ai][m][0], rt[ai][m][1]);
            st16(P.kr() + (size_t)tok * 64 + c0, pack8(v));
          }
        } else {
#pragma unroll
          for (int j = 0; j < 8; j++) v[j] = 1.f + __expf(fminf(-v[j], 69.f));
          st16(dbase + (size_t)tok * ldo + coff + c0, pack8(v));
        }
      }
      if (KIND == 4) {
        s2 += shx(s2, lane, 16); s2 += shx(s2, lane, 32);
        if (fq == 0) sbase[(size_t)tok * 8 + wc] = s2;
      } else if (KIND == 6) {
        s1 += shx(s1, lane, 16); s1 += shx(s1, lane, 32);
        s2 += shx(s2, lane, 16); s2 += shx(s2, lane, 32);
        if (fq == 0) { float* d = sbase + ((size_t)tok * 16 + wc) * 2; d[0] = s1; d[1] = s2; }
      }
    }
  }
}
struct EpiG1 {
  static constexpr bool CHAIN = false;
  const Params& P;
  DI void operator()(const f32x4 (&acc)[2][2][4][2], const pg8::Unit& u, int wr, int wc, int fr, int fq) const {
    asm volatile("" : "+v"(fr), "+v"(fq));
    const int pn = u.pn;
    if (pn < 4) g1_body<0>(P, acc, u, wr, wc, fr, fq, P.q_a(), 1024, pn * 256, nullptr);
    else if (pn == 4) g1_body<1>(P, acc, u, wr, wc, fr, fq, P.k_a(), 256, 0, nullptr);
    else if (pn == 5) g1_body<2>(P, acc, u, wr, wc, fr, fq, nullptr, 0, 0, nullptr);
    else if (pn < 10) g1_body<3>(P, acc, u, wr, wc, fr, fq, P.saz(), 1024, (pn - 6) * 256, nullptr);
    else if (pn < 12) g1_body<4>(P, acc, u, wr, wc, fr, fq, P.cq(), 512, (pn - 10) * 256, P.ssq_q() + (pn - 10) * 4);
    else if (pn < 14) g1_body<4>(P, acc, u, wr, wc, fr, fq, P.ckv(), 512, (pn - 12) * 256, P.ssq_kv() + (pn - 12) * 4);
    else if (pn < 18) g1_body<3>(P, acc, u, wr, wc, fr, fq, P.sbz(), 1024, (pn - 14) * 256, nullptr);
    else if (pn < 22) g1_body<5>(P, acc, u, wr, wc, fr, fq, P.cu(), 1024, (pn - 18) * 256, nullptr);
    else if (pn < 26) g1_body<6>(P, acc, u, wr, wc, fr, fq, nullptr, 0, (pn - 22) * 256, P.cvst() + (pn - 22) * 8);
    else if (pn < 30) g1_body<3>(P, acc, u, wr, wc, fr, fq, P.scz(), 1024, (pn - 26) * 256, nullptr);
    else if (pn == 30) g1_body<7>(P, acc, u, wr, wc, fr, fq, nullptr, 0, 0, nullptr);
    else g1_body<8>(P, acc, u, wr, wc, fr, fq, P.sg(), 6144, (pn - 31) * 256, nullptr);
  }
};

struct EpiG2 {
  static constexpr bool CHAIN = false;
  const Params& P;
  DI void operator()(const f32x4 (&acc)[2][2][4][2], const pg8::Unit& u, int wr, int wc, int fr, int fq) const {
    asm volatile("" : "+v"(fr), "+v"(fq));
    const bool isq = u.pm < 68;
    const int pm = isq ? u.pm : u.pm - 68;
    const bool lat = pm < 64;
    float rsv[2][4];
    {
      f32x4 p0[2][4], p1[2][4];
#pragma unroll
      for (int ai = 0; ai < 2; ai++)
#pragma unroll
        for (int m = 0; m < 4; m++) {
          const int tok = pm * 256 + ai * 128 + wr * 64 + m * 16 + fr;
          const float* sp = (isq ? P.ssq_q() : P.ssq_kv()) + (size_t)tok * 8;
          p0[ai][m] = *(const f32x4_a*)sp; p1[ai][m] = *(const f32x4_a*)(sp + 4);
        }
      __builtin_amdgcn_sched_barrier(0);
#pragma unroll
      for (int ai = 0; ai < 2; ai++)
#pragma unroll
        for (int m = 0; m < 4; m++) {
          f32x4 a = p0[ai][m], b = p1[ai][m];
          rsv[ai][m] = rsqrtf((a.x + a.y + a.z + a.w + b.x + b.y + b.z + b.w) * (1.f / 512.f) + EPS);
        }
    }
#pragma unroll
    for (int ai = 0; ai < 2; ai++) {
#pragma unroll
      for (int m = 0; m < 4; m++) {
        const int tok = pm * 256 + ai * 128 + wr * 64 + m * 16 + fr;
        const int pos = tok & 4095;
        const int b = lat ? (tok >> 12) : ((tok - NLAT) >> 8);
        const float rs = rsv[ai][m];
#pragma unroll
        for (int bj = 0; bj < 2; bj++) {
          float v[8]; acc8(acc, ai, bj, m, v);
#pragma unroll
          for (int j = 0; j < 8; j++) v[j] *= rs;
          const int o = 32 * wc + 8 * fq, c0 = 128 * bj + o;
          if (isq) {
            const int n0 = u.pn * 256 + c0;
            const int hd = n0 % 192;
            if (lat && hd >= 128) {
              const int oo = hd - 128;
              const int axis = oo >> 5, i0 = (oo & 31) >> 1;
              const int p = axis ? (pos & 63) : (pos >> 6);
              rope8(v, P.tab16() + (size_t)(p * 16 + i0) * 2);
            }
            st16(P.q_b() + (size_t)tok * 1536 + n0, pack8(v));
          } else {
            const int head = u.pn - 6;
            if (bj == 0) {
              st16(P.kn_b() + (size_t)tok * 1024 + head * 128 + o, pack8(v));
            } else {
              u16* dst = lat ? P.vTb_lat() + ((size_t)(b * 8 + head) * 128 + o) * 4096 + vperm(pos)
                             : P.vTb_ctx() + ((size_t)(b * 8 + head) * 128 + o) * 256 + vperm((tok - NLAT) & 255);
              const size_t ld = lat ? 4096 : 256;
#pragma unroll
              for (int j = 0; j < 4; j++) { const unsigned pw = pack2(v[2 * j], v[2 * j + 1]); dst[(2 * j) * ld] = (u16)pw; dst[(2 * j + 1) * ld] = (u16)(pw >> 16); }
            }
          }
        }
      }
    }
  }
};
struct OrderG1 {
  int G, c, l;
  DI bool next(int i, pg8::Unit& u) const {
    const int L = i * G + c;
    if (l == 0) { if (L >= 68 * 55) return false; pg8::grid_map(L, 68, 55, u.pm, u.pn); return true; }
    if (L < 64 * 55) { pg8::grid_map(L, 64, 55, u.pm, u.pn); return true; }
    const int j = L - 64 * 55;
    if (j >= 20) return false;
    const int q = j >> 2;
    u.pm = 64 + (j & 3); u.pn = (q == 0) ? 4 : (q == 1) ? 5 : (q == 2) ? 12 : (q == 3) ? 13 : 30;
    return true;
  }
};
struct OrderG2 {
  int G, c, l;
  DI bool next(int i, pg8::Unit& u) const {
    const int L = i * G + c;
    const int nq = (l == 0) ? 408 : 384;
    if (L < nq) { pg8::grid_map(L, (l == 0) ? 68 : 64, 6, u.pm, u.pn); return true; }
    const int L2 = L - nq;
    if (L2 < 544) { pg8::grid_map(L2, 68, 8, u.pm, u.pn); u.pm += 68; u.pn += 6; return true; }
    return false;
  }
};

struct EpiG3 {
  static constexpr bool CHAIN = true;
  const Params& P;
  DI bool operator()(f32x4 (&acc)[2][2][4][2], const pg8::Unit& u, int wr, int wc, int fr, int fq) const {
    asm volatile("" : "+v"(fr), "+v"(fq));
    const int br = u.pm / 68, pm = u.pm - br * 68, pn = u.pn & 7;
    const int col = pn * 256 + 32 * wc + 8 * fq;
#pragma unroll
    for (int ai = 0; ai < 2; ai++) {
      const int tok0 = pm * 256 + ai * 128 + wr * 64 + fr;
      const u16* gp = P.sg() + (size_t)tok0 * 6144 + br * 2048 + col;
      u32x4 G[4][2], H[4][2];
#pragma unroll
      for (int m = 0; m < 4; m++)
#pragma unroll
        for (int bj = 0; bj < 2; bj++) {
          G[m][bj] = ld16(gp + (size_t)m * 16 * 6144 + bj * 128);
          H[m][bj] = (br < 2) ? ld16(gp + (size_t)m * 16 * 6144 + bj * 128 + 2048) : G[m][bj];
        }
      __builtin_amdgcn_sched_barrier(0);
#pragma unroll
      for (int m = 0; m < 4; m++)
#pragma unroll
        for (int bj = 0; bj < 2; bj++) {
          float g[8]; unpack8(G[m][bj], g);
#pragma unroll
          for (int j = 0; j < 8; j++) g[j] = __builtin_amdgcn_rcpf(g[j]);
          if (br < 2) {
            float g2[8]; unpack8(H[m][bj], g2);
#pragma unroll
            for (int j = 0; j < 8; j++) g[j] *= g2[j];
          }
          f32x4 a0 = acc[ai][bj][m][0], a1 = acc[ai][bj][m][1];
          a0.x *= g[0]; a0.y *= g[1]; a0.z *= g[2]; a0.w *= g[3]; a1.x *= g[4]; a1.y *= g[5]; a1.z *= g[6]; a1.w *= g[7];
          if (br < 2) { acc[ai][bj][m][0] = a0; acc[ai][bj][m][1] = a1; }
          else {
            u32x4 w; w.x = pack2(a0.x, a0.y); w.y = pack2(a0.z, a0.w); w.z = pack2(a1.x, a1.y); w.w = pack2(a1.z, a1.w);
            st16(P.m() + (size_t)(tok0 + m * 16) * DM + col + bj * 128, w);
          }
        }
    }
    return br < 2;
  }
};
struct OrderG3 {
  int G, c, MTu;
  DI bool next(int i, pg8::Unit& u) const {
    const int rt = i / 3, br = i - rt * 3;
    const int tI = rt * G + c;
    if (tI >= MTu * 8) return false;
    int pm, pn; pg8::grid_map(tI, MTu, 8, pm, pn);
    u.pm = br * 68 + pm; u.pn = br * 8 + pn; return true;
  }
};

struct EpiG4 {
  static constexpr bool CHAIN = false;
  const Params& P; int l;
  DI void operator()(const f32x4 (&acc)[2][2][4][2], const pg8::Unit& u, int wr, int wc, int fr, int fq) const {
    asm volatile("" : "+v"(fr), "+v"(fq));
    const bool lat = u.pm < 64;
    const int mrow = lat ? (u.pm >> 4) : 4;
    const int col = u.pn * 256 + 32 * wc + 8 * fq;
    const float* gp = P.mod() + (size_t)(l * 5 + mrow) * 6144 + 4096 + col;
    f32x4 gv[2][2];
#pragma unroll
    for (int bj = 0; bj < 2; bj++) { gv[bj][0] = *(const f32x4_a*)(gp + bj * 128); gv[bj][1] = *(const f32x4_a*)(gp + bj * 128 + 4); }
#pragma unroll
    for (int ai = 0; ai < 2; ai++) {
      const int tok0 = u.pm * 256 + ai * 128 + wr * 64 + fr;
      const float* xin = (l == 0) ? (lat ? P.x + (size_t)tok0 * DM : P.ctx + (size_t)(tok0 - NLAT) * DM)
                                  : (lat ? P.out + (size_t)tok0 * DM : P.xres() + (size_t)(tok0 - NLAT) * DM);
      float* xo = lat ? P.out + (size_t)tok0 * DM : P.xres() + (size_t)(tok0 - NLAT) * DM;
      f32x4 X[4][2][2];
#pragma unroll
      for (int m = 0; m < 4; m++)
#pragma unroll
        for (int bj = 0; bj < 2; bj++) {
          X[m][bj][0] = *(const f32x4_a*)(xin + (size_t)m * 16 * DM + col + bj * 128);
          X[m][bj][1] = *(const f32x4_a*)(xin + (size_t)m * 16 * DM + col + bj * 128 + 4);
        }
      __builtin_amdgcn_sched_barrier(0);
#pragma unroll
      for (int m = 0; m < 4; m++)
#pragma unroll
        for (int bj = 0; bj < 2; bj++) {
          *(f32x4_a*)(xo + (size_t)m * 16 * DM + col + bj * 128) = X[m][bj][0] + gv[bj][0] * acc[ai][bj][m][0];
          *(f32x4_a*)(xo + (size_t)m * 16 * DM + col + bj * 128 + 4) = X[m][bj][1] + gv[bj][1] * acc[ai][bj][m][1];
        }
    }
  }
};

DI int win_src(int n) {
  if (n < 1280) {
    int head = n >> 7, p = n & 127, blk = p >> 6, q = p & 63;
    return head * 128 + blk * 64 + (q & 1) * 32 + (q >> 1);
  }
  if (n < 3584) return n;
  if (n < 7680) return n + 64;
  if (n < 7744) { int p = n - 7680, blk = p >> 5, q = p & 31; return 3584 + blk * 32 + (q & 1) * 16 + (q >> 1); }
  if (n < 7936) return -1;
  return n - 192;
}
DI int uq_src(int n) {
  int head = n / 192, p = n - head * 192;
  if (p < 128) return n;
  int pp = p - 128, blk = pp >> 5, q = pp & 31;
  return head * 192 + 128 + blk * 32 + (q & 1) * 16 + (q >> 1);
}
template <int MAP>
DI void transpose_item(const float* __restrict__ src, int ld_src, int k0, int n0, const float* kscale,
                       u16* __restrict__ dst, int K, char* smem, int tid) {
  float* tl = (float*)smem;
  const int kk0 = tid >> 6;
  const bool vec = (MAP == 0) || (MAP == 1 && n0 >= 1280 && n0 != 7680);
  if (vec) {
    const int nq = tid & 63;
    int sc = n0 + nq * 4;
    if (MAP == 1) sc = win_src(sc);
    f32x4 v4[16];
#pragma unroll
    for (int i = 0; i < 16; i++) v4[i] = *(const f32x4_a*)(src + (size_t)(k0 + kk0 + 4 * i) * ld_src + sc);
    const int q = nq >> 4, nn = (nq & 15) * 4;
#pragma unroll
    for (int i = 0; i < 16; i++) {
      int kk = kk0 + 4 * i;
      float ksc = kscale ? kscale[k0 + kk] : 1.f;
      float* d = tl + (q * 64 + kk) * 65 + nn;
      d[0] = v4[i].x * ksc; d[1] = v4[i].y * ksc; d[2] = v4[i].z * ksc; d[3] = v4[i].w * ksc;
    }
  } else {
    const int nn = tid & 63;
    float v[4][16];
#pragma unroll
    for (int q = 0; q < 4; q++) {
      int sc = n0 + q * 64 + nn;
      if (MAP == 1) sc = win_src(sc);
      if (MAP == 2) sc = uq_src(sc);
#pragma unroll
      for (int i = 0; i < 16; i++) {
        int kk = kk0 + 4 * i;
        v[q][i] = (sc < 0) ? 0.f : src[(size_t)(k0 + kk) * ld_src + sc];
      }
    }
#pragma unroll
    for (int q = 0; q < 4; q++)
#pragma unroll
      for (int i = 0; i < 16; i++) {
        int kk = kk0 + 4 * i;
        float x = v[q][i];
        if (kscale) x *= kscale[k0 + kk];
        tl[(q * 64 + kk) * 65 + nn] = x;
      }
  }
  __syncthreads();
  const int n = tid >> 2, ks = (tid & 3) * 16;
#pragma unroll
  for (int q = 0; q < 4; q++) {
    const float* t = tl + (q * 64) * 65;
    u32x4 o0, o1;
    o0.x = pack2(t[(ks + 0) * 65 + n], t[(ks + 1) * 65 + n]);
    o0.y = pack2(t[(ks + 2) * 65 + n], t[(ks + 3) * 65 + n]);
    o0.z = pack2(t[(ks + 4) * 65 + n], t[(ks + 5) * 65 + n]);
    o0.w = pack2(t[(ks + 6) * 65 + n], t[(ks + 7) * 65 + n]);
    o1.x = pack2(t[(ks + 8) * 65 + n], t[(ks + 9) * 65 + n]);
    o1.y = pack2(t[(ks + 10) * 65 + n], t[(ks + 11) * 65 + n]);
    o1.z = pack2(t[(ks + 12) * 65 + n], t[(ks + 13) * 65 + n]);
    o1.w = pack2(t[(ks + 14) * 65 + n], t[(ks + 15) * 65 + n]);
    u16* d = dst + (size_t)(n0 + q * 64 + n) * K + k0 + ks;
    st16(d, o0); st16(d + 8, o1);
  }
  __syncthreads();
}

DI void ada_item(const Params& P, int it, char* smem) {
  const int tid = otid() & 255;
  const int l = it / 192, cc = it % 192;
  float* sc = (float*)smem;
  for (int i = tid; i < 5 * 2048; i += 256) {
    int r = i >> 11, k = i & 2047;
    float v = (r < 4) ? P.c[r * 2048 + k] : P.c_ctx[k];
    sc[i] = v / (1.f + expf(-v));
  }
  __syncthreads();
  const int cl = tid & 31, kg = tid >> 5;
  const float* wp = P.ada_w + (size_t)l * 2048 * 6144 + cc * 32 + cl;
  float a0 = 0.f, a1 = 0.f, a2 = 0.f, a3 = 0.f, a4 = 0.f;
#pragma unroll 8
  for (int k = kg * 256; k < kg * 256 + 256; k++) {
    float wv = wp[(size_t)k * 6144];
    a0 += wv * sc[k]; a1 += wv * sc[2048 + k]; a2 += wv * sc[4096 + k]; a3 += wv * sc[6144 + k]; a4 += wv * sc[8192 + k];
  }
  float* red = (float*)(smem + 40960);
  red[(kg * 5 + 0) * 32 + cl] = a0; red[(kg * 5 + 1) * 32 + cl] = a1; red[(kg * 5 + 2) * 32 + cl] = a2;
  red[(kg * 5 + 3) * 32 + cl] = a3; red[(kg * 5 + 4) * 32 + cl] = a4;
  __syncthreads();
  if (tid < 160) {
    int r = tid >> 5, c2 = tid & 31;
    float s = 0.f;
    for (int g = 0; g < 8; g++) s += red[(g * 5 + r) * 32 + c2];
    P.mod()[(size_t)(l * 5 + r) * 6144 + cc * 32 + c2] = s + P.ada_b[l * 6144 + cc * 32 + c2];
  }
  __syncthreads();
}


constexpr int W_ADA = 384, W_SGU = 128, W_TAB = 2;
constexpr int W_PRE = W_ADA + W_SGU + W_TAB;
constexpr int W_L_WIN = 55 * 32, W_L_UQ = 6 * 8, W_L_UKV = 8 * 8, W_L_WP = 3 * 8 * 16, W_L_WOUT = 8 * 32;
constexpr int W_L = W_L_WIN + W_L_UQ + W_L_UKV + W_L_WP + W_L_WOUT;

DI void phase_w(const Params& P, int l, int bid, int nb, char* smem0) {
  const int half = otid() >> 8, tid = otid() & 255;
  char* smem = smem0 + half * HALF_SMEM;
  const int pre = (l == 0) ? W_PRE : 0;
  const int total = pre + W_L;
  for (int it2 = bid; it2 * 2 < total; it2 += nb) {
    const int it = it2 * 2 + half;
    if (it < pre) {
      if (it < W_ADA) { ada_item(P, it, smem); continue; }
      int i = it - W_ADA;
      if (i < W_SGU) {
        size_t base = (size_t)i * 2048 + tid * 8;
        f32x4 a = *(const f32x4_a*)(P.sgu_w + base), b = *(const f32x4_a*)(P.sgu_w + base + 4);
        u32x4 o; o.x = pack2(a.x, a.y); o.y = pack2(a.z, a.w); o.z = pack2(b.x, b.y); o.w = pack2(b.z, b.w);
        st16(P.SguW() + base, o);
        continue;
      }
      i -= W_SGU;
      if (i == 0) {
        for (int e = tid; e < 64 * 32; e += 256) {
          int pos = e >> 5, fi = e & 31;
          float inv = powf(10000.f, -(float)fi / 32.f);
          float ang = (float)pos * inv;
          P.tab32()[e * 2] = cosf(ang); P.tab32()[e * 2 + 1] = sinf(ang);
        }
      } else {
        for (int e = tid; e < 64 * 16; e += 256) {
          int pos = e >> 4, fi = e & 15;
          float inv = powf(10000.f, -(float)fi / 16.f);
          float ang = (float)pos * inv;
          P.tab16()[e * 2] = cosf(ang); P.tab16()[e * 2 + 1] = sinf(ang);
        }
      }
      continue;
    }
    int i = it - pre;
    if (i < W_L_WIN) {
      int nbk = i >> 5, kb = i & 31;
      transpose_item<1>(P.w_in + (size_t)l * 2048 * 13888, 13888, kb * 64, nbk * 256, nullptr, P.WinT(), 2048, smem, tid);
      continue;
    }
    i -= W_L_WIN;
    if (i < W_L_UQ) {
      int nbk = i >> 3, kb = i & 7;
      transpose_item<2>(P.w_uq + (size_t)l * 512 * 1536, 1536, kb * 64, nbk * 256, P.mla_gq + l * 512, P.WuqT(), 512, smem, tid);
      continue;
    }
    i -= W_L_UQ;
    if (i < W_L_UKV) {
      int nbk = i >> 3, kb = i & 7;
      transpose_item<0>(P.w_ukv + (size_t)l * 512 * 2048, 2048, kb * 64, nbk * 256, P.mla_gkv + l * 512, P.WukvT(), 512, smem, tid);
      continue;
    }
    i -= W_L_UKV;
    if (i < W_L_WP) {
      int br = i / 128, j = i % 128;
      int nbk = j >> 4, kb = j & 15;
      const float* src = (br == 0 ? P.w_pa : (br == 1 ? P.w_pb : P.w_pc)) + (size_t)l * 1024 * 2048;
      transpose_item<0>(src, 2048, kb * 64, nbk * 256, nullptr, P.WpT() + (size_t)br * 2048 * 1024, 1024, smem, tid);
      continue;
    }
    i -= W_L_WP;
    {
      int nbk = i >> 5, kb = i & 31;
      transpose_item<0>(P.w_out + (size_t)l * 2048 * 2048, 2048, kb * 64, nbk * 256, nullptr, P.WoutT(), 2048, smem, tid);
    }
  }
}

DI void phase_norm(const Params& P, int l, int bid, int nb) {
  const int tid = otid(), lane = tid & 63, w = tid >> 6;
  for (int t = bid * 8 + w; t < T_TOK; t += nb * 8) {
    const float* src = (l == 0) ? (t < NLAT ? P.x + (size_t)t * DM : P.ctx + (size_t)(t - NLAT) * DM)
                                : (t < NLAT ? P.out + (size_t)t * DM : P.xres() + (size_t)(t - NLAT) * DM);
    const int mrow = t < NLAT ? (t >> 12) : 4;
    const float* md = P.mod() + (size_t)(l * 5 + mrow) * 6144;
    f32x4 v[8];
    float ss = 0.f;
#pragma unroll
    for (int i = 0; i < 8; i++) {
      v[i] = *(const f32x4_a*)(src + (lane + 64 * i) * 4);
      ss += v[i].x * v[i].x + v[i].y * v[i].y + v[i].z * v[i].z + v[i].w * v[i].w;
    }
#pragma unroll
    for (int o = 32; o >= 1; o >>= 1) ss += shx(ss, lane, o);
    const float rinv = rsqrtf(ss * (1.f / 2048.f) + EPS);
#pragma unroll
    for (int i = 0; i < 8; i++) {
      int c = (lane + 64 * i) * 4;
      f32x4 g = *(const f32x4_a*)(P.norm_g + l * 2048 + c);
      f32x4 sh = *(const f32x4_a*)(md + c);
      f32x4 sc = *(const f32x4_a*)(md + 2048 + c);
      float o0 = v[i].x * rinv * g.x * (1.f + sc.x) + sh.x;
      float o1 = v[i].y * rinv * g.y * (1.f + sc.y) + sh.y;
      float o2 = v[i].z * rinv * g.z * (1.f + sc.z) + sh.z;
      float o3 = v[i].w * rinv * g.w * (1.f + sc.w) + sh.w;
      u32x2 o; o.x = pack2(o0, o1); o.y = pack2(o2, o3);
      *(u32x2_a*)(P.h() + (size_t)t * DM + c) = o;
    }
  }
}

DI void phase_final(const Params& P, int bid, int nb) {
  const int tid = otid(), lane = tid & 63, w = tid >> 6;
  for (int t = bid * 8 + w; t < NLAT; t += nb * 8) {
    float* src = P.out + (size_t)t * DM;
    f32x4 v[8];
    float ss = 0.f;
#pragma unroll
    for (int i = 0; i < 8; i++) {
      v[i] = *(const f32x4_a*)(src + (lane + 64 * i) * 4);
      ss += v[i].x * v[i].x + v[i].y * v[i].y + v[i].z * v[i].z + v[i].w * v[i].w;
    }
#pragma unroll
    for (int o = 32; o >= 1; o >>= 1) ss += shx(ss, lane, o);
    const float rinv = rsqrtf(ss * (1.f / 2048.f) + EPS);
#pragma unroll
    for (int i = 0; i < 8; i++) {
      int c = (lane + 64 * i) * 4;
      f32x4 g = *(const f32x4_a*)(P.final_g + c);
      f32x4 o; o.x = v[i].x * rinv * g.x; o.y = v[i].y * rinv * g.y; o.z = v[i].z * rinv * g.z; o.w = v[i].w * rinv * g.w;
      *(f32x4_a*)(src + c) = o;
    }
  }
}

constexpr int VST = 144;
constexpr int SV_OFF = 25600;

struct AttnArgs {
  const u16* Q; int ldq;
  const u16* K1; int ldk1;
  const u16* K2;
  int seg0_row, seg0_n; const u16* seg0_vT; int seg0_ldv;
  int seg1_row, seg1_n; const u16* seg1_vT; int seg1_ldv;
  int qpos0, kpos0; bool mask0;
  bool has_sink; float sink_l2; float cscale;
  const u16* gate; u16* out;
};

constexpr int ATT_BUF = 45056;
template <int DQK>
DI void attn_item(const AttnArgs& a, char* smem) {
  constexpr int NS = DQK / 16;
  constexpr int KST = DQK * 2 + 16;
  const int tid = otid(), lane = tid & 63, w = tid >> 6, lr = lane & 31, hh = lane >> 5;

  bf16x8 qf[NS];
  {
    const u16* qp = a.Q + (size_t)(w * 32 + lr) * a.ldq + hh * 8;
#pragma unroll
    for (int s = 0; s < NS; s++) qf[s] = *(const bf16x8_a*)(qp + s * 16);
  }
  const int nt0 = a.seg0_n >> 6, ntot = nt0 + (a.seg1_n >> 6);
  u32x4 pk[3], pv[2];
  auto prefetch = [&](int tl) {
    int krow; const u16* vsrc; int ldv;
    if (tl < nt0) { krow = a.seg0_row + tl * 64; vsrc = a.seg0_vT + tl * 64; ldv = a.seg0_ldv; }
    else { int t2 = tl - nt0; krow = a.seg1_row + t2 * 64; vsrc = a.seg1_vT + t2 * 64; ldv = a.seg1_ldv; }
    const u16* p1 = a.K1 + (size_t)(krow + (tid >> 4)) * a.ldk1 + (tid & 15) * 8;
    pk[0] = ld16(p1); pk[1] = ld16(p1 + (size_t)32 * a.ldk1);
    if (DQK == 192) pk[2] = ld16(a.K2 + (size_t)(krow + (tid >> 3)) * 64 + (tid & 7) * 8);
    const u16* p3 = vsrc + (size_t)(tid >> 3) * ldv + (tid & 7) * 8;
    pv[0] = ld16(p3); pv[1] = ld16(p3 + (size_t)64 * ldv);
  };
  auto stash = [&](char* buf) {
    char* sK = buf; char* sV = buf + SV_OFF;
    st16(sK + (tid >> 4) * KST + (tid & 15) * 16, pk[0]);
    st16(sK + ((tid >> 4) + 32) * KST + (tid & 15) * 16, pk[1]);
    if (DQK == 192) st16(sK + (tid >> 3) * KST + 256 + (tid & 7) * 16, pk[2]);
    st16(sV + (tid >> 3) * VST + (tid & 7) * 16, pv[0]);
    st16(sV + ((tid >> 3) + 64) * VST + (tid & 7) * 16, pv[1]);
  };
  f32x16 O[4];
#pragma unroll
  for (int d = 0; d < 4; d++)
#pragma unroll
    for (int i = 0; i < 16; i++) O[d][i] = 0.f;
  float m = a.has_sink ? a.sink_l2 : -1e30f;
  float l = (a.has_sink && hh == 0) ? 1.f : 0.f;
  const int qp = a.qpos0 + w * 32 + lr;
  const int qlo = a.qpos0 + w * 32;

  prefetch(0);
  stash(smem);
  __syncthreads();
  if (ntot > 1) prefetch(1);
  for (int tl = 0; tl < ntot; tl++) {
    const char* sK = smem + (tl & 1) * ATT_BUF;
    const char* sV = sK + SV_OFF;
    const bool domask = a.mask0 && (tl < nt0);
    const int k0 = a.kpos0 + tl * 64;
    const bool skip = domask && ((k0 > qlo + 31 + 128) || (k0 + 63 < qlo - 128));
    if (!skip) {
      f32x16 S0, S1;
#pragma unroll
      for (int i = 0; i < 16; i++) { S0[i] = 0.f; S1[i] = 0.f; }
      {
        constexpr int NC = NS / 4;
        const char* kp0 = sK + lr * KST + hh * 16;
        const char* kp1 = kp0 + 32 * KST;
        bf16x8 ka[4], kb[4];
        __builtin_amdgcn_s_setprio(1);
#pragma unroll
        for (int s = 0; s < 4; s++) ka[s] = *(const bf16x8_a*)(kp0 + s * 32);
#pragma unroll
        for (int s = 0; s < 4; s++) kb[s] = *(const bf16x8_a*)(kp1 + s * 32);
        __builtin_amdgcn_sched_barrier(0);
#pragma unroll
        for (int c = 0; c < NC; c++) {
#pragma unroll
          for (int s = 0; s < 4; s++) {
            S0 = mfma32(ka[s], qf[c * 4 + s], S0);
            S1 = mfma32(kb[s], qf[c * 4 + s], S1);
            if (c + 1 < NC) {
              ka[s] = *(const bf16x8_a*)(kp0 + ((c + 1) * 4 + s) * 32);
              kb[s] = *(const bf16x8_a*)(kp1 + ((c + 1) * 4 + s) * 32);
            }
          }
          __builtin_amdgcn_sched_barrier(0);
        }
        __builtin_amdgcn_s_setprio(0);
      }
      if (domask) {
        const int kbase = k0 - qp;
#pragma unroll
        for (int i = 0; i < 16; i++) {
          int d0 = kbase + crow(i, hh), d1 = d0 + 32;
          if (d0 > 128 || d0 < -128) S0[i] = -1e30f;
          if (d1 > 128 || d1 < -128) S1[i] = -1e30f;
        }
      }
      const float m0 = fmaxf(S1[14], S1[15]);
      float mA = max3f(m0, S0[0], S0[1]), mB = max3f(m0, S1[0], S1[1]);
#pragma unroll
      for (int i = 1; i < 8; i++) mA = max3f(mA, S0[2 * i], S0[2 * i + 1]);
#pragma unroll
      for (int i = 1; i < 7; i++) mB = max3f(mB, S1[2 * i], S1[2 * i + 1]);
      float mx = max3f(mA, mB, mB);
      mx = fmaxf(mx, shx(mx, lane, 32)) * a.cscale;
      if (__builtin_amdgcn_ballot_w64(mx > m + 8.f) != 0) {
        const float mnew = fmaxf(m, mx);
        const float alpha = __builtin_amdgcn_exp2f(m - mnew);
        m = mnew;
        l *= alpha;
#pragma unroll
        for (int d = 0; d < 4; d++)
#pragma unroll
          for (int i = 0; i < 16; i++) O[d][i] *= alpha;
      }
      float ls = 0.f;
#pragma unroll
      for (int i = 0; i < 16; i++) {
        float p0 = __builtin_amdgcn_exp2f(fmaf(S0[i], a.cscale, -m)), p1 = __builtin_amdgcn_exp2f(fmaf(S1[i], a.cscale, -m));
        S0[i] = p0; S1[i] = p1; ls += p0; ls += p1;
      }
      l += ls;
      u32x4 pp4[4];
#pragma unroll
      for (int sh = 0; sh < 2; sh++) {
        pp4[sh].x = pack2(S0[8 * sh + 0], S0[8 * sh + 1]); pp4[sh].y = pack2(S0[8 * sh + 2], S0[8 * sh + 3]);
        pp4[sh].z = pack2(S0[8 * sh + 4], S0[8 * sh + 5]); pp4[sh].w = pack2(S0[8 * sh + 6], S0[8 * sh + 7]);
        pp4[2 + sh].x = pack2(S1[8 * sh + 0], S1[8 * sh + 1]); pp4[2 + sh].y = pack2(S1[8 * sh + 2], S1[8 * sh + 3]);
        pp4[2 + sh].z = pack2(S1[8 * sh + 4], S1[8 * sh + 5]); pp4[2 + sh].w = pack2(S1[8 * sh + 6], S1[8 * sh + 7]);
      }
      __builtin_amdgcn_s_setprio(1);
      const char* vbase = sV + lr * VST + 8 * hh * 2;
      bf16x8 va[4], vb[4];
#pragma unroll
      for (int dt = 0; dt < 4; dt++) va[dt] = *(const bf16x8_a*)(vbase + dt * 32 * VST);
#pragma unroll
      for (int dt = 0; dt < 4; dt++) vb[dt] = *(const bf16x8_a*)(vbase + dt * 32 * VST + 32);
      __builtin_amdgcn_sched_barrier(0);
      {
        const bf16x8 pf = __builtin_bit_cast(bf16x8, pp4[0]);
#pragma unroll
        for (int dt = 0; dt < 4; dt++) { O[dt] = mfma32(va[dt], pf, O[dt]); va[dt] = *(const bf16x8_a*)(vbase + dt * 32 * VST + 64); }
      }
      __builtin_amdgcn_sched_barrier(0);
      {
        const bf16x8 pf = __builtin_bit_cast(bf16x8, pp4[1]);
#pragma unroll
        for (int dt = 0; dt < 4; dt++) { O[dt] = mfma32(vb[dt], pf, O[dt]); vb[dt] = *(const bf16x8_a*)(vbase + dt * 32 * VST + 96); }
      }
      __builtin_amdgcn_sched_barrier(0);
      {
        const bf16x8 pf = __builtin_bit_cast(bf16x8, pp4[2]);
#pragma unroll
        for (int dt = 0; dt < 4; dt++) O[dt] = mfma32(va[dt], pf, O[dt]);
      }
      {
        const bf16x8 pf = __builtin_bit_cast(bf16x8, pp4[3]);
#pragma unroll
        for (int dt = 0; dt < 4; dt++) O[dt] = mfma32(vb[dt], pf, O[dt]);
      }
      __builtin_amdgcn_s_setprio(0);
    }
    if (tl + 1 < ntot) stash(smem + ((tl + 1) & 1) * ATT_BUF);
    __syncthreads();
    if (tl + 2 < ntot) prefetch(tl + 2);
  }
  const float lt = l + shx(l, lane, 32);
  const float linv = 1.f / lt;
  {
    constexpr int OST = 272;
    char* ot = smem + w * (32 * OST);
#pragma unroll
    for (int dt = 0; dt < 4; dt++)
#pragma unroll
      for (int g4 = 0; g4 < 4; g4++) {
        const int d = dt * 32 + 8 * g4 + 4 * hh;
        u32x2 ov;
        ov.x = pack2(O[dt][4 * g4 + 0] * linv, O[dt][4 * g4 + 1] * linv);
        ov.y = pack2(O[dt][4 * g4 + 2] * linv, O[dt][4 * g4 + 3] * linv);
        *(u32x2_a*)(ot + lr * OST + d * 2) = ov;
      }
    __builtin_amdgcn_fence(__ATOMIC_RELEASE, "wavefront");
    asm volatile("s_waitcnt lgkmcnt(0)" ::: "memory");
#pragma unroll
    for (int i = 0; i < 8; i++) {
      const int id = lane + 64 * i, row = id >> 4, cc = id & 15;
      const size_t go = (size_t)(w * 32 + row) * 1024 + cc * 8;
      float ov[8], gv[8];
      unpack8(ld16(ot + row * OST + cc * 16), ov);
      unpack8(ld16(a.gate + go), gv);
#pragma unroll
      for (int j = 0; j < 8; j++) ov[j] *= gv[j];
      st16(a.out + go, pack8(ov));
    }
  }
  __syncthreads();
}

DI void attnA_any(const Params& P, int l, int it, char* smem) {
  const bool isl = it < 512;
  const int ia = isl ? it : it - 512;
  const int hq = ia & 7, kvh = hq >> 2;
  const int qsb = isl ? ((ia >> 3) & 15) : 0;
  const int b = isl ? (ia >> 7) : (ia >> 3);
  AttnArgs a;
  const size_t tq = isl ? ((size_t)b * 4096 + qsb * 256) : ((size_t)NLAT + b * 256);
  a.Q = P.q_a() + tq * 1024 + hq * 128; a.ldq = 1024;
  a.K1 = P.k_a() + kvh * 128; a.ldk1 = 256; a.K2 = P.k_a();
  int ks = qsb * 256 - 128; if (ks < 0) ks = 0;
  int ke = qsb * 256 + 384; if (ke > 4096) ke = 4096;
  const u16* vctx = P.vTa_ctx() + ((size_t)(b * 2 + kvh) * 128) * 256;
  if (isl) {
    a.seg0_row = b * 4096 + ks; a.seg0_n = ke - ks;
    a.seg0_vT = P.vTa_lat() + ((size_t)(b * 2 + kvh) * 128) * 4096 + ks; a.seg0_ldv = 4096;
    a.seg1_row = NLAT + b * 256; a.seg1_n = 256; a.seg1_vT = vctx; a.seg1_ldv = 256;
    a.qpos0 = qsb * 256; a.kpos0 = ks; a.mask0 = true;
  } else {
    a.seg0_row = NLAT + b * 256; a.seg0_n = 256; a.seg0_vT = vctx; a.seg0_ldv = 256;
    a.seg1_row = 0; a.seg1_n = 0; a.seg1_vT = vctx; a.seg1_ldv = 256;
    a.qpos0 = 0; a.kpos0 = 0; a.mask0 = false;
  }
  a.has_sink = true; a.sink_l2 = P.sink_a[l * 8 + hq] * LOG2E;
  a.cscale = 0.08838834764831845f * LOG2E;
  a.gate = P.saz() + tq * 1024 + hq * 128; a.out = P.ya() + tq * 1024 + hq * 128;
  attn_item<128>(a, smem);
}
DI void attnB_any(const Params& P, int it, char* smem, bool dummy = false) {
  const bool isl = it < 512;
  const int ia = isl ? it : it - 512;
  const int hq = ia & 7;
  const int qsb = isl ? ((ia >> 3) & 15) : 0;
  const int b = isl ? (ia >> 7) : (ia >> 3);
  AttnArgs a;
  const size_t tq = isl ? ((size_t)b * 4096 + qsb * 256) : ((size_t)NLAT + b * 256);
  a.Q = P.q_b() + tq * 1536 + hq * 192; a.ldq = 1536;
  a.K1 = P.kn_b() + hq * 128; a.ldk1 = 1024; a.K2 = P.kr();
  const u16* vctx = P.vTb_ctx() + ((size_t)(b * 8 + hq) * 128) * 256;
  if (isl) {
    a.seg0_row = b * 4096; a.seg0_n = 4096;
    a.seg0_vT = P.vTb_lat() + ((size_t)(b * 8 + hq) * 128) * 4096; a.seg0_ldv = 4096;
    a.seg1_row = NLAT + b * 256; a.seg1_n = 256; a.seg1_vT = vctx; a.seg1_ldv = 256;
  } else {
    a.seg0_row = NLAT + b * 256; a.seg0_n = 256; a.seg0_vT = vctx; a.seg0_ldv = 256;
    a.seg1_row = 0; a.seg1_n = 0; a.seg1_vT = vctx; a.seg1_ldv = 256;
  }
  a.qpos0 = 0; a.kpos0 = 0; a.mask0 = false;
  a.has_sink = false; a.sink_l2 = 0.f;
  a.cscale = 0.07216878364870322f * LOG2E;
  a.gate = P.sbz() + tq * 1024 + hq * 128; a.out = (dummy ? P.h() : P.yb()) + tq * 1024 + hq * 128;
  attn_item<192>(a, smem);
}

constexpr int SGU_ST = 272;
DI void sgu_item(const Params& P, int l, int ch, int g, char* smem) {
  const int tid = otid() & 255, lane = tid & 63, w = tid >> 6, wr = w >> 1, wc = w & 1, lr = lane & 31, hh = lane >> 5;
  float* st = (float*)(smem + 2 * 128 * SGU_ST);
  if (tid < 128) {
    const float* sp = P.cvst() + (size_t)(ch * 128 + tid) * 32;
    float s1 = 0.f, s2 = 0.f;
#pragma unroll
    for (int j = 0; j < 16; j++) { s1 += sp[2 * j]; s2 += sp[2 * j + 1]; }
    float mu = s1 * (1.f / 1024.f);
    float var = s2 * (1.f / 1024.f) - mu * mu;
    st[tid * 2] = mu; st[tid * 2 + 1] = rsqrtf(fmaxf(var, 0.f) + EPS);
  }
  __syncthreads();
  char* sA = smem; char* sB = smem + 128 * SGU_ST;
  const u16* Ag = P.SguW() + (size_t)(l * 8 + g) * 128 * 128;
  const u16* Bg = P.cvT() + ((size_t)ch * 1024 + g * 128) * 128;
#pragma unroll
  for (int i = 0; i < 8; i++) {
    int id = tid + 256 * i, r = id >> 4, cc = id & 15;
    st16(sA + r * SGU_ST + cc * 16, ld16(Ag + r * 128 + cc * 8));
    float v[8]; unpack8(ld16(Bg + r * 128 + cc * 8), v);
    float gam = P.sgu_ln_g[l * 1024 + g * 128 + r], bet = P.sgu_ln_b[l * 1024 + g * 128 + r];
#pragma unroll
    for (int e = 0; e < 8; e++) {
      int q = cc * 8 + e;
      v[e] = (v[e] - st[2 * q]) * st[2 * q + 1] * gam + bet;
    }
    st16(sB + r * SGU_ST + cc * 16, pack8(v));
  }
  __syncthreads();
  f32x16 acc[2][2]; zero_acc(acc);
  {
    const char* pa = sA + (wr * 64 + lr) * SGU_ST + hh * 16;
    const char* pb = sB + (wc * 64 + lr) * SGU_ST + hh * 16;
#pragma unroll
    for (int s = 0; s < 8; s++) {
      bf16x8 a0 = *(const bf16x8_a*)(pa + s * 32);
      bf16x8 a1 = *(const bf16x8_a*)(pa + 32 * SGU_ST + s * 32);
      bf16x8 b0 = *(const bf16x8_a*)(pb + s * 32);
      bf16x8 b1 = *(const bf16x8_a*)(pb + 32 * SGU_ST + s * 32);
      acc[0][0] = mfma32(a0, b0, acc[0][0]);
      acc[0][1] = mfma32(a0, b1, acc[0][1]);
      acc[1][0] = mfma32(a1, b0, acc[1][0]);
      acc[1][1] = mfma32(a1, b1, acc[1][1]);
    }
  }
  __syncthreads();
  float* stg = (float*)smem;
  stage_acc(acc, stg, tid);
  __syncthreads();
#pragma unroll
  for (int j = 0; j < 8; j++) {
    int id = tid + 256 * j, r = id >> 4, c8 = (id & 15) * 8;
    float v[8]; ldstg8(stg, r, c8, v);
    const size_t off = (size_t)(ch * 128 + r) * 1024 + g * 128 + c8;
    float u[8], z[8];
    unpack8(ld16(P.cu() + off), u); unpack8(ld16(P.scz() + off), z);
    float bs = P.sgu_b[(l * 8 + g) * 128 + r];
#pragma unroll
    for (int e = 0; e < 8; e++) v[e] = u[e] * (v[e] + bs) * z[e];
    st16(P.yc() + off, pack8(v));
  }
  __syncthreads();
}


DI void phase_g1(const Params& P, int l, int bid, int nb, char* smem) {
  OrderG1 S{nb, bid, l};
  EpiG1 E{P};
  pg8::gemm_phase(( PG8_LAS unsigned char*)smem, P.h(), P.WinT(), 2048, S, E);
}
DI void phase_g2(const Params& P, int l, int bid, int nb, char* smem) {
  const int half = otid() >> 8;
  char* hs = smem + half * HALF_SMEM;
  const int na = (l == 0) ? 544 : 512;
  for (int it = bid; it < na; it += nb) attnA_any(P, l, it, smem);
  {
    OrderG2 S{nb, bid, l};
    EpiG2 E{P};
    pg8::gemm_phase((PG8_LAS unsigned char*)smem, P.cq(), P.WuqT(), 512, S, E);
  }
  const int nch = (l == 0) ? 136 : 128;
  for (int it2 = bid; it2 * 2 < nch * 8; it2 += nb) { const int it = it2 * 2 + half; sgu_item(P, l, it >> 3, it & 7, hs); }
}
DI void phase_attb(const Params& P, int l, int bid, int nb, char* smem) {
  const int half = otid() >> 8;
  char* hs = smem + half * HALF_SMEM;
  const int na = (l == 0) ? 544 : 512;
#if MK_DUP & 2
  for (int it = bid; it < na; it += nb) attnB_any(P, it, smem, true);
#endif
  for (int it = bid; it < na; it += nb) attnB_any(P, it, smem);
}
DI void phase_g3(const Params& P, int l, int bid, int nb, char* smem) {
  OrderG3 S{nb, bid, (l == 0) ? 68 : 64};
  EpiG3 E{P};
  pg8::gemm_phase((PG8_LAS unsigned char*)smem, P.ya(), P.WpT(), 1024, S, E);
}
DI void phase_g4(const Params& P, int l, int bid, int nb, char* smem) {
  pg8::GridOrder S; S.init((l == 0) ? 68 : 64, 8, nb, bid);
  EpiG4 E{P, l};
  pg8::gemm_phase((PG8_LAS unsigned char*)smem, P.m(), P.WoutT(), 2048, S, E);
}

DI void run_phase(const Params& P, int ph, int bid, int nb, char* smem) {
  if (ph == 0) { phase_w(P, 0, bid, nb, smem); return; }
  if (ph == 13) { phase_final(P, bid, nb); return; }
  const int l = (ph - 1) / 6, s = (ph - 1) % 6;
  switch (s) {
    case 0: phase_norm(P, l, bid, nb); if (l == 1) phase_w(P, 1, bid, nb, smem); break;
    case 1: phase_g1(P, l, bid, nb, smem); break;
    case 2: phase_g2(P, l, bid, nb, smem); break;
    case 3: phase_attb(P, l, bid, nb, smem); break;
    case 4: phase_g3(P, l, bid, nb, smem); break;
    default: phase_g4(P, l, bid, nb, smem); break;
  }
}

extern __shared__ __attribute__((aligned(16))) char dyn_smem[];

DI void fast_grid_sync(unsigned* bar, unsigned k, unsigned nb) {
  asm volatile("s_waitcnt vmcnt(0)" ::: "memory");
  __syncthreads();
  if (threadIdx.x == 0) {
    __builtin_amdgcn_fence(__ATOMIC_RELEASE, "agent");
    asm volatile("s_waitcnt vmcnt(0)" ::: "memory");
    const unsigned g = blockIdx.x >> 4;
    const unsigned ngroups = (nb + 15u) >> 4;
    const unsigned gsz = (g + 1u == ngroups) ? nb - g * 16u : 16u;
    unsigned* rel = bar + 32 * 17;
    const unsigned old = __hip_atomic_fetch_add(bar + 32 * g, 1u, __ATOMIC_RELAXED, __HIP_MEMORY_SCOPE_AGENT);
    if (old + 1u == k * gsz) {
      const unsigned t = __hip_atomic_fetch_add(bar + 32 * 16, 1u, __ATOMIC_RELAXED, __HIP_MEMORY_SCOPE_AGENT);
      if (t + 1u == k * ngroups) __hip_atomic_store(rel, k, __ATOMIC_RELAXED, __HIP_MEMORY_SCOPE_AGENT);
    }
    while (__hip_atomic_load(rel, __ATOMIC_RELAXED, __HIP_MEMORY_SCOPE_AGENT) < k) __builtin_amdgcn_s_sleep(1);
    __builtin_amdgcn_fence(__ATOMIC_ACQUIRE, "agent");
    asm volatile("s_waitcnt vmcnt(0)" ::: "memory");
  }
  __syncthreads();
}

#if MK_MULTI
__global__ void __launch_bounds__(NTHR, 2) k_phase(Params P, int ph) {
  run_phase(P, ph, blockIdx.x, gridDim.x, dyn_smem);
}
#endif

#if !MK_MULTI
__global__ void __launch_bounds__(NTHR, 2) k_mega(Params P) {
  const int bid = blockIdx.x, nb = gridDim.x;
  unsigned* ctr = (unsigned*)(P.ws + WS_BAR);
  unsigned nsync = 0;
#define GSYNC() do { nsync += 1u; fast_grid_sync(ctr, nsync, (unsigned)nb); } while (0)
  phase_w(P, 0, bid, nb, dyn_smem);
  if (nb < 0) cg::this_grid().sync();
  GSYNC();
#pragma unroll 1
  for (int l = 0; l < 2; l++) {
    phase_norm(P, l, bid, nb);
    if (l == 1) phase_w(P, 1, bid, nb, dyn_smem);
    GSYNC();
#if MK_DUP & 1
    phase_g1(P, l, bid, nb, dyn_smem); GSYNC();
#endif
    phase_g1(P, l, bid, nb, dyn_smem); GSYNC();
    phase_g2(P, l, bid, nb, dyn_smem); GSYNC();
    phase_attb(P, l, bid, nb, dyn_smem); GSYNC();
#if MK_DUP & 4
    phase_g3(P, l, bid, nb, dyn_smem); GSYNC();
#endif
    phase_g3(P, l, bid, nb, dyn_smem); GSYNC();
    phase_g4(P, l, bid, nb, dyn_smem); GSYNC();
  }
  phase_final(P, bid, nb);
#undef GSYNC
}
#endif

__global__ void k_fill(float* o, int n, float v) { int i = blockIdx.x * 256 + threadIdx.x; if (i < n) o[i] = v; }

extern "C" void kernel_launch(void* const* d_in, const int* in_sizes, int n_in, void* d_out, int out_size, void* d_ws,
                              size_t ws_size, hipStream_t stream) {
  static int grid_blocks = 0;
  if (!grid_blocks) {
    int dev = 0, cus = 0, per_cu = 0;
    hipGetDevice(&dev);
    hipDeviceGetAttribute(&cus, hipDeviceAttributeMultiprocessorCount, dev);
#if MK_MULTI
    const void* kfn = (const void*)k_phase;
#else
    const void* kfn = (const void*)k_mega;
#endif
    hipFuncSetAttribute(kfn, hipFuncAttributeMaxDynamicSharedMemorySize, SMEM_BYTES);
    hipOccupancyMaxActiveBlocksPerMultiprocessor(&per_cu, kfn, NTHR, SMEM_BYTES);
    if (per_cu < 1) per_cu = 1;
    grid_blocks = cus;
    (void)hipGetLastError();
  }
  Params P{};
  const float** ins = (const float**)&P;
  for (int i = 0; i < 22; i++) ins[i] = (const float*)d_in[i];
  P.out = (float*)d_out;
  P.ws = (char*)d_ws;
  if (WS_TOTAL > ws_size || grid_blocks > 256) {
    fprintf(stderr, "workspace too small or unexpected grid\n");
    hipLaunchKernelGGL(k_fill, dim3((out_size + 255) / 256), dim3(256), 0, stream, (float*)d_out, out_size, 7777.f);
    return;
  }
#if MK_MULTI
  for (int ph = 0; ph < 14; ph++) hipLaunchKernelGGL(k_phase, dim3(grid_blocks), dim3(NTHR), SMEM_BYTES, stream, P, ph);
#else
  hipMemsetAsync((char*)d_ws + WS_BAR, 0, 4096, stream);
  void* args[] = {&P};
  hipError_t e = hipLaunchCooperativeKernel((const void*)k_mega, dim3(grid_blocks), dim3(NTHR), args, SMEM_BYTES, stream);
  if (e != hipSuccess) fprintf(stderr, "cooperative launch failed: %s (grid %d)\n", hipGetErrorString(e), grid_blocks);
#endif
}
```

```cpp
#include <hip/hip_runtime.h>
#include <hip/hip_cooperative_groups.h>
#include <cstdio>
namespace cg = cooperative_groups;

#ifndef MK_MULTI
#define MK_MULTI 0
#endif
#ifndef MK_DUP
#define MK_DUP 0
#endif

typedef unsigned short u16;
typedef __attribute__((ext_vector_type(8))) short bf16x8;
typedef __attribute__((ext_vector_type(4))) short s16x4;
typedef __attribute__((ext_vector_type(16))) float f32x16;
typedef __attribute__((ext_vector_type(4))) float f32x4;
typedef __attribute__((ext_vector_type(4))) unsigned u32x4;
typedef __attribute__((ext_vector_type(2))) unsigned u32x2;
typedef u32x4 __attribute__((may_alias)) u32x4_a;
typedef u32x2 __attribute__((may_alias)) u32x2_a;
typedef f32x4 __attribute__((may_alias)) f32x4_a;
typedef bf16x8 __attribute__((may_alias)) bf16x8_a;
typedef s16x4 __attribute__((may_alias)) s16x4_a;

#define DI __device__ __forceinline__

constexpr int T_TOK = 17408, NLAT = 16384, DM = 2048;
constexpr int NIN = 14080;
constexpr float EPS = 1e-6f;
constexpr float LOG2E = 1.4426950408889634f;

constexpr int NTHR = 512;
constexpr int CST = 132;
constexpr int HALF_SMEM = 70656;
constexpr int SMEM_BYTES = 2 * HALF_SMEM;

struct Params {
  const float *x, *c, *ctx, *c_ctx, *ada_w, *ada_b, *norm_g, *w_in, *sink_a, *mla_gq, *mla_gkv, *w_uq, *w_ukv,
      *sgu_ln_g, *sgu_ln_b, *sgu_w, *sgu_b, *w_pa, *w_pb, *w_pc, *w_out, *final_g;
  float* out;
  char* ws;
  DI u16* WinT() const { return (u16*)(ws + 0ull); }
  DI u16* WuqT() const { return (u16*)(ws + 57671680ull); }
  DI u16* WukvT() const { return (u16*)(ws + 59244544ull); }
  DI u16* WpT() const { return (u16*)(ws + 61341696ull); }
  DI u16* WoutT() const { return (u16*)(ws + 73924608ull); }
  DI u16* SguW() const { return (u16*)(ws + 82313216ull); }
  DI u16* h() const { return (u16*)(ws + 83107840ull); }
  DI u16* q_a() const { return (u16*)(ws + 738795520ull); }
  DI u16* k_a() const { return (u16*)(ws + 510926848ull); }
  DI u16* vTa_lat() const { return (u16*)(ws + 519839744ull); }
  DI u16* vTa_ctx() const { return (u16*)(ws + 528228352ull); }
  DI u16* saz() const { return (u16*)(ws + 154411008ull); }
  DI u16* cq() const { return (u16*)(ws + 261365760ull); }
  DI u16* ckv() const { return (u16*)(ws + 279191552ull); }
  DI u16* sbz() const { return (u16*)(ws + 190062592ull); }
  DI u16* cu() const { return (u16*)(ws + 528752640ull); }
  DI u16* cvT() const { return (u16*)(ws + 564404224ull); }
  DI u16* scz() const { return (u16*)(ws + 225714176ull); }
  DI u16* sg() const { return (u16*)(ws + 297017344ull); }
  DI u16* kr() const { return (u16*)(ws + 600055808ull); }
  DI u16* q_b() const { return (u16*)(ws + 614014976ull); }
  DI u16* kn_b() const { return (u16*)(ws + 667492352ull); }
  DI u16* vTb_lat() const { return (u16*)(ws + 703143936ull); }
  DI u16* vTb_ctx() const { return (u16*)(ws + 736698368ull); }
  DI u16* ya() const { return (u16*)(ws + 154411008ull); }
  DI u16* yb() const { return (u16*)(ws + 190062592ull); }
  DI u16* yc() const { return (u16*)(ws + 225714176ull); }
  DI u16* m() const { return (u16*)(ws + 614014976ull); }
  DI float* mod() const { return (float*)(ws + 82837504ull); }
  DI float* tab32() const { return (float*)(ws + 83083264ull); }
  DI float* tab16() const { return (float*)(ws + 83099648ull); }
  DI float* ssq_q() const { return (float*)(ws + 602284032ull); }
  DI float* ssq_kv() const { return (float*)(ws + 602841088ull); }
  DI float* cvst() const { return (float*)(ws + 603398144ull); }
  DI float* xres() const { return (float*)(ws + 605626368ull); }
  DI float* gscr() const { return (float*)(ws + 685318144ull); }
};
constexpr size_t WS_BAR = 774447104ull;
constexpr size_t WS_TOTAL = 774451200ull;

DI u16 f2bf(float x) { unsigned u = __float_as_uint(x); u += 0x7fffu + ((u >> 16) & 1u); return (u16)(u >> 16); }
typedef __attribute__((ext_vector_type(2))) float f32x2_t;
typedef __attribute__((ext_vector_type(2))) __bf16 bf16x2_t;
DI unsigned pack2(float a, float b) { f32x2_t v = {a, b}; return __builtin_bit_cast(unsigned, __builtin_convertvector(v, bf16x2_t)); }
DI float bf_lo(unsigned v) { return __uint_as_float(v << 16); }
DI float bf_hi(unsigned v) { return __uint_as_float(v & 0xffff0000u); }
DI u32x4 ld16(const void* p) { return *(const u32x4_a*)p; }
DI void st16(void* p, u32x4 v) { *(u32x4_a*)p = v; }
DI f32x16 mfma32(bf16x8 a, bf16x8 b, f32x16 c) { return __builtin_amdgcn_mfma_f32_32x32x16_bf16(a, b, c, 0, 0, 0); }
DI float siluf(float v) { return v * __builtin_amdgcn_rcpf(1.f + __expf(-v)); }
DI float sigmf(float v) { return __builtin_amdgcn_rcpf(1.f + __expf(-v)); }
DI int otid() { int t = threadIdx.x; asm volatile("" : "+v"(t)); return t; }
DI float shx(float v, int lane, int o) { return __int_as_float(__builtin_amdgcn_ds_bpermute((lane ^ o) << 2, __float_as_int(v))); }
DI int vperm(int t) { return (t & ~15) | (t & 3) | (((t >> 2) & 1) << 3) | (((t >> 3) & 1) << 2); }
DI float max3f(float a, float b, float c) { float r; asm("v_max3_f32 %0, %1, %2, %3" : "=v"(r) : "v"(a), "v"(b), "v"(c)); return r; }
DI u32x2 halves(float v) { return __builtin_amdgcn_permlane32_swap(__float_as_uint(v), __float_as_uint(v), false, false); }
DI int crow(int i, int hh) { return (i & 3) + 8 * (i >> 2) + 4 * hh; }
DI void unpack8(u32x4 v, float (&f)[8]) {
  f[0] = bf_lo(v.x); f[1] = bf_hi(v.x); f[2] = bf_lo(v.y); f[3] = bf_hi(v.y);
  f[4] = bf_lo(v.z); f[5] = bf_hi(v.z); f[6] = bf_lo(v.w); f[7] = bf_hi(v.w);
}
DI u32x4 pack8(const float (&f)[8]) {
  u32x4 r; r.x = pack2(f[0], f[1]); r.y = pack2(f[2], f[3]); r.z = pack2(f[4], f[5]); r.w = pack2(f[6], f[7]); return r;
}
DI void ldstg8(const float* stg, int r, int c8, float (&v)[8]) {
  f32x4 a = *(const f32x4_a*)(stg + r * CST + c8), b = *(const f32x4_a*)(stg + r * CST + c8 + 4);
  v[0] = a.x; v[1] = a.y; v[2] = a.z; v[3] = a.w; v[4] = b.x; v[5] = b.y; v[6] = b.z; v[7] = b.w;
}
DI void zero_acc(f32x16 (&acc)[2][2]) {
#pragma unroll
  for (int a = 0; a < 2; a++)
#pragma unroll
    for (int b = 0; b < 2; b++)
#pragma unroll
      for (int i = 0; i < 16; i++) acc[a][b][i] = 0.f;
}
DI void stage_acc(const f32x16 (&acc)[2][2], float* stg, int tid) {
  const int lane = tid & 63, w = tid >> 6, wr = w >> 1, wc = w & 1, lr = lane & 31, hh = lane >> 5;
#pragma unroll
  for (int ta = 0; ta < 2; ta++)
#pragma unroll
    for (int tb = 0; tb < 2; tb++)
#pragma unroll
      for (int i = 0; i < 16; i++) {
        int row = wr * 64 + ta * 32 + crow(i, hh), col = wc * 64 + tb * 32 + lr;
        stg[row * CST + col] = acc[ta][tb][i];
      }
}

#define PG8_LAS __attribute__((address_space(3)))
namespace pg8 {
constexpr int BM = 256, BK = 64, HALF = 128, HTB = HALF * BK * 2, STAGE_BYTES = 8 * HTB, NXCD = 8, WGM = 8;
DI int lds_byte(int r, int c) { const int st = (r >> 4) * 2 + (c >> 5), rr = r & 15, cc = c & 31, ob = rr * 64 + cc * 2; return st * 1024 + (ob ^ (((ob >> 9) & 1) << 5)); }
DI void stage_rc(int b, int& R, int& C) { const int st = b / 1024, sb = b % 1024, swz = sb ^ (((sb >> 9) & 1) << 5); R = (st >> 1) * 16 + swz / 64; C = (st & 1) * 32 + (swz % 64) / 2; }
DI int perm32(int rho) { const int n = rho >> 4, i = rho & 15; return 8 * (i >> 2) + 4 * n + (i & 3); }
struct Unit { int pm, pn; };

template <class Epi, class Sched>
DI void gemm_phase(PG8_LAS unsigned char* lds, const u16* Abase, const u16* Btbase, const int K, const Sched& S, const Epi& E) {
    const int tid = otid(), wid = __builtin_amdgcn_readfirstlane(tid >> 6), lane = tid & 63, wr = wid >> 2, wc = wid & 3, fr = lane & 15, fq = lane >> 4;
    const int nt = K / BK;
    unsigned voffA[2], voffB[2];
#pragma unroll
    for (int i = 0; i < 2; ++i) { int R, C; stage_rc(tid * 16 + i * 8192, R, C); const int Rb = (R & ~31) + perm32(R & 31);
        voffA[i] = (unsigned)(R * K + C) * 2u; voffB[i] = (unsigned)(Rb * K + C) * 2u; }
    const size_t kstep = (size_t)(BK * 2);
    const size_t hstep = (size_t)HALF * K * 2;
    const size_t tstep = 2 * hstep;
    const unsigned ldsw = (unsigned)wid * 1024u;
    const int aoff = lds_byte(wr * 64 + fr, fq * 8), boff = lds_byte(wc * 32 + fr, fq * 8);
#define PG8_SA(b, h) (((b) * 2 + (h)) * HTB)
#define PG8_SB(b, h) ((4 + (b) * 2 + (h)) * HTB)
#define PG8_STAGE(bufoff, gbase, voff) do { _Pragma("unroll") for (int _i = 0; _i < 2; ++_i) \
        __builtin_amdgcn_global_load_lds((const unsigned*)((const char*)(gbase) + (voff)[_i]), (PG8_LAS unsigned*)(lds + (bufoff) + ldsw + _i * 8192), 16, 0, 0); } while (0)
#define PG8_LDA(dst, b, h) do { _Pragma("unroll") for (int m = 0; m < 4; ++m) _Pragma("unroll") for (int k = 0; k < 2; ++k) dst[m][k] = *(const PG8_LAS bf16x8*)(lds + PG8_SA(b, h) + aoff + m * 2048 + k * 1024); } while (0)
#define PG8_LDB(dst, b, h) do { _Pragma("unroll") for (int n = 0; n < 2; ++n) _Pragma("unroll") for (int k = 0; k < 2; ++k) dst[n][k] = *(const PG8_LAS bf16x8*)(lds + PG8_SB(b, h) + boff + n * 2048 + k * 1024); } while (0)
#define PG8_MMA(ai, bj, At, Bt) do { __builtin_amdgcn_s_setprio(1); _Pragma("unroll") for (int m = 0; m < 4; ++m) _Pragma("unroll") for (int n = 0; n < 2; ++n) _Pragma("unroll") for (int k = 0; k < 2; ++k) \
        acc[ai][bj][m][n] = __builtin_amdgcn_mfma_f32_16x16x32_bf16(Bt[n][k], At[m][k], acc[ai][bj][m][n], 0, 0, 0); __builtin_amdgcn_s_setprio(0); } while (0)
#define PG8_WAIT_V(n) asm volatile("s_waitcnt vmcnt(" #n ")" ::: "memory")
#define PG8_WAIT_L(n) asm volatile("s_waitcnt lgkmcnt(" #n ")" ::: "memory")
#define PG8_BAR __builtin_amdgcn_s_barrier()
#define PG8_SCHED __builtin_amdgcn_sched_barrier(0)
    Unit cur, nxt; int ui = 0;
    if (!S.next(0, cur)) return;
    f32x4 acc[2][2][4][2];
#pragma unroll
    for (int a = 0; a < 2; ++a)
#pragma unroll
        for (int b = 0; b < 2; ++b)
#pragma unroll
            for (int m = 0; m < 4; ++m)
#pragma unroll
                for (int n = 0; n < 2; ++n) acc[a][b][m][n] = (f32x4){0.f, 0.f, 0.f, 0.f};
    bf16x8 At[4][2], B0[2][2], B1[2][2];
    const char* cA = (const char*)Abase + (size_t)cur.pm * tstep; const char* cB = (const char*)Btbase + (size_t)cur.pn * tstep;
    PG8_STAGE(PG8_SB(0, 0), cB, voffB); PG8_STAGE(PG8_SA(0, 0), cA, voffA); PG8_STAGE(PG8_SB(0, 1), cB + hstep, voffB); PG8_STAGE(PG8_SA(0, 1), cA + hstep, voffA);
    if (wr == 1) PG8_BAR;
    PG8_WAIT_V(4); PG8_BAR;
    PG8_STAGE(PG8_SB(1, 0), cB + kstep, voffB); PG8_STAGE(PG8_SA(1, 0), cA + kstep, voffA); PG8_STAGE(PG8_SB(1, 1), cB + hstep + kstep, voffB);
    PG8_WAIT_V(6); PG8_BAR;
    for (;;) {
        const bool has_next = S.next(ui + 1, nxt);
        const char* nA = has_next ? (const char*)Abase + (size_t)nxt.pm * tstep : cA; const char* nB = has_next ? (const char*)Btbase + (size_t)nxt.pn * tstep : cB;
        for (int t = 0; t < nt; t += 2) {
            const bool last = (t == nt - 2);
            const char* a1 = cA + (size_t)(t + 1) * kstep;
            const char* a2 = last ? nA : cA + (size_t)(t + 2) * kstep; const char* b2 = last ? nB : cB + (size_t)(t + 2) * kstep;
            const char* a3 = a2 + kstep; const char* b3 = b2 + kstep;
            PG8_LDB(B0, 0, 0); PG8_SCHED; PG8_LDA(At, 0, 0); PG8_STAGE(PG8_SA(1, 1), a1 + hstep, voffA);
            PG8_WAIT_L(8); PG8_BAR; PG8_WAIT_L(0); PG8_MMA(0, 0, At, B0); PG8_BAR; PG8_SCHED;
            PG8_LDB(B1, 0, 1); PG8_STAGE(PG8_SB(0, 0), b2, voffB);
            PG8_BAR; PG8_WAIT_L(0); PG8_MMA(0, 1, At, B1); PG8_BAR;
            PG8_LDA(At, 0, 1); PG8_STAGE(PG8_SA(0, 0), a2, voffA);
            PG8_BAR; PG8_WAIT_L(0); PG8_MMA(1, 0, At, B0); PG8_BAR; PG8_SCHED;
            PG8_STAGE(PG8_SB(0, 1), b2 + hstep, voffB);
            PG8_WAIT_V(6); PG8_BAR; PG8_MMA(1, 1, At, B1); PG8_BAR;
            PG8_LDB(B0, 1, 0); PG8_SCHED; PG8_LDA(At, 1, 0); PG8_STAGE(PG8_SA(0, 1), a2 + hstep, voffA);
            PG8_WAIT_L(8); PG8_BAR; PG8_WAIT_L(0); PG8_MMA(0, 0, At, B0); PG8_BAR; PG8_SCHED;
            PG8_LDB(B1, 1, 1); PG8_STAGE(PG8_SB(1, 0), b3, voffB);
            PG8_BAR; PG8_WAIT_L(0); PG8_MMA(0, 1, At, B1); PG8_BAR;
            PG8_LDA(At, 1, 1); PG8_STAGE(PG8_SA(1, 0), a3, voffA);
            PG8_BAR; PG8_WAIT_L(0); PG8_MMA(1, 0, At, B0); PG8_BAR; PG8_SCHED;
            PG8_STAGE(PG8_SB(1, 1), b3 + hstep, voffB);
            PG8_WAIT_V(6); PG8_BAR; PG8_MMA(1, 1, At, B1); PG8_BAR;
        }
        bool keep = false;
        if constexpr (Epi::CHAIN) keep = E(acc, cur, wr, wc, fr, fq); else E(acc, cur, wr, wc, fr, fq);
        if (!has_next) break;
        if (!keep) {
#pragma unroll
        for (int a = 0; a < 2; ++a)
#pragma unroll
            for (int b = 0; b < 2; ++b)
#pragma unroll
                for (int m = 0; m < 4; ++m)
#pragma unroll
                    for (int n = 0; n < 2; ++n) acc[a][b][m][n] = (f32x4){0.f, 0.f, 0.f, 0.f};
        }
        cur = nxt; cA = nA; cB = nB; ++ui;
    }
    PG8_WAIT_V(0);
    if (wr == 0) PG8_BAR;
    PG8_BAR;
#undef PG8_SA
#undef PG8_SB
#undef PG8_STAGE
#undef PG8_LDA
#undef PG8_LDB
#undef PG8_MMA
#undef PG8_WAIT_V
#undef PG8_WAIT_L
#undef PG8_BAR
#undef PG8_SCHED
}

DI void grid_map(int L, int nM, int nN, int& pm, int& pn) {
    const int nwg = nM * nN;
    int wgid = L; { const int q = nwg / NXCD, r = nwg % NXCD, xcd = wgid % NXCD, off = wgid / NXCD; wgid = (xcd < r ? xcd * (q + 1) : r * (q + 1) + (xcd - r) * q) + off; }
    const int nig = WGM * nN, gid = wgid / nig, fm = gid * WGM, gsz = (nM - fm) < WGM ? (nM - fm) : WGM;
    pm = fm + ((wgid % nig) % gsz); pn = (wgid % nig) / gsz;
}
struct GridOrder {
    int nM, nN, nwg, G, c;
    DI void init(int nM_, int nN_, int G_, int c_) { nM = nM_; nN = nN_; nwg = nM * nN; G = G_; c = c_; }
    DI bool next(int i, Unit& u) const {
        const int L = i * G + c; if (L >= nwg) return false;
        int wgid = L; { const int q = nwg / NXCD, r = nwg % NXCD, xcd = wgid % NXCD, off = wgid / NXCD; wgid = (xcd < r ? xcd * (q + 1) : r * (q + 1) + (xcd - r) * q) + off; }
        const int nig = WGM * nN, gid = wgid / nig, fm = gid * WGM, gsz = (nM - fm) < WGM ? (nM - fm) : WGM;
        u.pm = fm + ((wgid % nig) % gsz); u.pn = (wgid % nig) / gsz; return true;
    }
};
}

DI void acc8(const f32x4 (&acc)[2][2][4][2], int ai, int bj, int m, float (&v)[8]) {
  f32x4 a = acc[ai][bj][m][0], b = acc[ai][bj][m][1];
  v[0] = a.x; v[1] = a.y; v[2] = a.z; v[3] = a.w; v[4] = b.x; v[5] = b.y; v[6] = b.z; v[7] = b.w;
}
DI void rope8v(float (&v)[8], f32x4 t0, f32x4 t1) {
  float a, b;
  a = v[0]; b = v[1]; v[0] = a * t0.x - b * t0.y; v[1] = a * t0.y + b * t0.x;
  a = v[2]; b = v[3]; v[2] = a * t0.z - b * t0.w; v[3] = a * t0.w + b * t0.z;
  a = v[4]; b = v[5]; v[4] = a * t1.x - b * t1.y; v[5] = a * t1.y + b * t1.x;
  a = v[6]; b = v[7]; v[6] = a * t1.z - b * t1.w; v[7] = a * t1.w + b * t1.z;
}

DI void rope8(float (&v)[8], const float* tb) { rope8v(v, *(const f32x4_a*)tb, *(const f32x4_a*)(tb + 4)); }

template <int KIND>
DI void g1_body(const Params& P, const f32x4 (&acc)[2][2][4][2], const pg8::Unit& u, int wr, int wc, int fr, int fq,
                u16* dbase, int ldo, int coff, float* sbase) {
  const int lane = otid() & 63;
  const bool lat = u.pm < 64;
  f32x4 rt[2][4][2];
  if ((KIND == 0 || KIND == 1 || KIND == 7) && lat) {
    const int o = 32 * wc + 8 * fq;
    const int axis = (KIND == 7) ? ((o & 63) >> 5) : (o >> 6);
    const int i0 = (KIND == 7) ? ((o & 31) >> 1) : ((o & 63) >> 1);
    const float* tbase = (KIND == 7) ? P.tab16() : P.tab32();
    const int half = (KIND == 7) ? 16 : 32;
#pragma unroll
    for (int ai = 0; ai < 2; ai++)
#pragma unroll
      for (int m = 0; m < 4; m++) {
        const int pos = (u.pm * 256 + ai * 128 + wr * 64 + m * 16 + fr) & 4095;
        const int p = axis ? (pos & 63) : (pos >> 6);
        const float* tb = tbase + (size_t)(p * half + i0) * 2;
        rt[ai][m][0] = *(const f32x4_a*)tb; rt[ai][m][1] = *(const f32x4_a*)(tb + 4);
      }
    __builtin_amdgcn_sched_barrier(0);
  }
#pragma unroll
  for (int ai = 0; ai < 2; ai++) {
#pragma unroll
    for (int m = 0; m < 4; m++) {
      const int tok = u.pm * 256 + ai * 128 + wr * 64 + m * 16 + fr;
      const int pos = tok & 4095;
      const int b = lat ? (tok >> 12) : ((tok - NLAT) >> 8);
      float s1 = 0.f, s2 = 0.f;
#pragma unroll
      for (int bj = 0; bj < 2; bj++) {
        float v[8]; acc8(acc, ai, bj, m, v);
        const int o = 32 * wc + 8 * fq;
        const int c0 = 128 * bj + o;
        if (KIND == 0 || KIND == 1) {
          if (lat) rope8v(v, rt[ai][m][0], rt[ai][m][1]);
          st16(dbase + (size_t)tok * ldo + coff + c0, pack8(v));
        } else if (KIND == 2) {
          u16* dst = lat ? P.vTa_lat() + ((size_t)(b * 2 + bj) * 128 + o) * 4096 + vperm(pos)
                         : P.vTa_ctx() + ((size_t)(b * 2 + bj) * 128 + o) * 256 + vperm((tok - NLAT) & 255);
          const size_t ld = lat ? 4096 : 256;
#pragma unroll
          for (int j = 0; j < 4; j++) { const unsigned pw = pack2(v[2 * j], v[2 * j + 1]); dst[(2 * j) * ld] = (u16)pw; dst[(2 * j + 1) * ld] = (u16)(pw >> 16); }
        } else if (KIND == 3) {
#pragma unroll
          for (int j = 0; j < 8; j++) v[j] = siluf(v[j]);
          st16(dbase + (size_t)tok * ldo + coff + c0, pack8(v));
        } else if (KIND == 4) {
          st16(dbase + (size_t)tok * ldo + coff + c0, pack8(v));
#pragma unroll
          for (int j = 0; j < 8; j++) s2 += v[j] * v[j];
        } else if (KIND == 5) {
          st16(dbase + (size_t)tok * ldo + coff + c0, pack8(v));
        } else if (KIND == 6) {
          u16* dst = P.cvT() + ((size_t)(tok >> 7) * 1024 + coff + c0) * 128 + (tok & 127);
#pragma unroll
          for (int j = 0; j < 4; j++) { const unsigned pw = pack2(v[2 * j], v[2 * j + 1]); dst[(2 * j) * 128] = (u16)pw; dst[(2 * j + 1) * 128] = (u16)(pw >> 16); }
#pragma unroll
          for (int j = 0; j < 8; j++) { s1 += v[j]; s2 += v[j] * v[j]; }
        } else if (KIND == 7) {
          if (c0 < 64) {
            if (lat) rope8v(v, rt[ai][m][0], rt[ai][m][1]);
            st16(P.kr() + (size_t)tok * 64 + c0, pack8(v));
          }
        } else {
#pragma unroll
          for (int j = 0; j < 8; j++) v[j] = 1.f + __expf(fminf(-v[j], 69.f));
          st16(dbase + (size_t)tok * ldo + coff + c0, pack8(v));
        }
      }
      if (KIND == 4) {
        s2 += shx(s2, lane, 16); s2 += shx(s2, lane, 32);
        if (fq == 0) sbase[(size_t)tok * 8 + wc] = s2;
      } else if (KIND == 6) {
        s1 += shx(s1, lane, 16); s1 += shx(s1, lane, 32);
        s2 += shx(s2, lane, 16); s2 += shx(s2, lane, 32);
        if (fq == 0) { float* d = sbase + ((size_t)tok * 16 + wc) * 2; d[0] = s1; d[1] = s2; }
      }
    }
  }
}
struct EpiG1 {
  static constexpr bool CHAIN = false;
  const Params& P;
  DI void operator()(const f32x4 (&acc)[2][2][4][2], const pg8::Unit& u, int wr, int wc, int fr, int fq) const {
    asm volatile("" : "+v"(fr), "+v"(fq));
    const int pn = u.pn;
    if (pn < 4) g1_body<0>(P, acc, u, wr, wc, fr, fq, P.q_a(), 1024, pn * 256, nullptr);
    else if (pn == 4) g1_body<1>(P, acc, u, wr, wc, fr, fq, P.k_a(), 256, 0, nullptr);
    else if (pn == 5) g1_body<2>(P, acc, u, wr, wc, fr, fq, nullptr, 0, 0, nullptr);
    else if (pn < 10) g1_body<3>(P, acc, u, wr, wc, fr, fq, P.saz(), 1024, (pn - 6) * 256, nullptr);
    else if (pn < 12) g1_body<4>(P, acc, u, wr, wc, fr, fq, P.cq(), 512, (pn - 10) * 256, P.ssq_q() + (pn - 10) * 4);
    else if (pn < 14) g1_body<4>(P, acc, u, wr, wc, fr, fq, P.ckv(), 512, (pn - 12) * 256, P.ssq_kv() + (pn - 12) * 4);
    else if (pn < 18) g1_body<3>(P, acc, u, wr, wc, fr, fq, P.sbz(), 1024, (pn - 14) * 256, nullptr);
    else if (pn < 22) g1_body<5>(P, acc, u, wr, wc, fr, fq, P.cu(), 1024, (pn - 18) * 256, nullptr);
    else if (pn < 26) g1_body<6>(P, acc, u, wr, wc, fr, fq, nullptr, 0, (pn - 22) * 256, P.cvst() + (pn - 22) * 8);
    else if (pn < 30) g1_body<3>(P, acc, u, wr, wc, fr, fq, P.scz(), 1024, (pn - 26) * 256, nullptr);
    else if (pn == 30) g1_body<7>(P, acc, u, wr, wc, fr, fq, nullptr, 0, 0, nullptr);
    else g1_body<8>(P, acc, u, wr, wc, fr, fq, P.sg(), 6144, (pn - 31) * 256, nullptr);
  }
};

struct EpiG2 {
  static constexpr bool CHAIN = false;
  const Params& P;
  DI void operator()(const f32x4 (&acc)[2][2][4][2], const pg8::Unit& u, int wr, int wc, int fr, int fq) const {
    asm volatile("" : "+v"(fr), "+v"(fq));
    const bool isq = u.pm < 68;
    const int pm = isq ? u.pm : u.pm - 68;
    const bool lat = pm < 64;
    float rsv[2][4];
    {
      f32x4 p0[2][4], p1[2][4];
#pragma unroll
      for (int ai = 0; ai < 2; ai++)
#pragma unroll
        for (int m = 0; m < 4; m++) {
          const int tok = pm * 256 + ai * 128 + wr * 64 + m * 16 + fr;
          const float* sp = (isq ? P.ssq_q() : P.ssq_kv()) + (size_t)tok * 8;
          p0[ai][m] = *(const f32x4_a*)sp; p1[ai][m] = *(const f32x4_a*)(sp + 4);
        }
      __builtin_amdgcn_sched_barrier(0);
#pragma unroll
      for (int ai = 0; ai < 2; ai++)
#pragma unroll
        for (int m = 0; m < 4; m++) {
          f32x4 a = p0[ai][m], b = p1[ai][m];
          rsv[ai][m] = rsqrtf((a.x + a.y + a.z + a.w + b.x + b.y + b.z + b.w) * (1.f / 512.f) + EPS);
        }
    }
#pragma unroll
    for (int ai = 0; ai < 2; ai++) {
#pragma unroll
      for (int m = 0; m < 4; m++) {
        const int tok = pm * 256 + ai * 128 + wr * 64 + m * 16 + fr;
        const int pos = tok & 4095;
        const int b = lat ? (tok >> 12) : ((tok - NLAT) >> 8);
        const float rs = rsv[ai][m];
#pragma unroll
        for (int bj = 0; bj < 2; bj++) {
          float v[8]; acc8(acc, ai, bj, m, v);
#pragma unroll
          for (int j = 0; j < 8; j++) v[j] *= rs;
          const int o = 32 * wc + 8 * fq, c0 = 128 * bj + o;
          if (isq) {
            const int n0 = u.pn * 256 + c0;
            const int hd = n0 % 192;
            if (lat && hd >= 128) {
              const int oo = hd - 128;
              const int axis = oo >> 5, i0 = (oo & 31) >> 1;
              const int p = axis ? (pos & 63) : (pos >> 6);
              rope8(v, P.tab16() + (size_t)(p * 16 + i0) * 2);
            }
            st16(P.q_b() + (size_t)tok * 1536 + n0, pack8(v));
          } else {
            const int head = u.pn - 6;
            if (bj == 0) {
              st16(P.kn_b() + (size_t)tok * 1024 + head * 128 + o, pack8(v));
            } else {
              u16* dst = lat ? P.vTb_lat() + ((size_t)(b * 8 + head) * 128 + o) * 4096 + vperm(pos)
                             : P.vTb_ctx() + ((size_t)(b * 8 + head) * 128 + o) * 256 + vperm((tok - NLAT) & 255);
              const size_t ld = lat ? 4096 : 256;
#pragma unroll
              for (int j = 0; j < 4; j++) { const unsigned pw = pack2(v[2 * j], v[2 * j + 1]); dst[(2 * j) * ld] = (u16)pw; dst[(2 * j + 1) * ld] = (u16)(pw >> 16); }
            }
          }
        }
      }
    }
  }
};
struct OrderG1 {
  int G, c, l;
  DI bool next(int i, pg8::Unit& u) const {
    const int L = i * G + c;
    if (l == 0) { if (L >= 68 * 55) return false; pg8::grid_map(L, 68, 55, u.pm, u.pn); return true; }
    if (L < 64 * 55) { pg8::grid_map(L, 64, 55, u.pm, u.pn); return true; }
    const int j = L - 64 * 55;
    if (j >= 20) return false;
    const int q = j >> 2;
    u.pm = 64 + (j & 3); u.pn = (q == 0) ? 4 : (q == 1) ? 5 : (q == 2) ? 12 : (q == 3) ? 13 : 30;
    return true;
  }
};
struct OrderG2 {
  int G, c, l;
  DI bool next(int i, pg8::Unit& u) const {
    const int L = i * G + c;
    const int nq = (l == 0) ? 408 : 384;
    if (L < nq) { pg8::grid_map(L, (l == 0) ? 68 : 64, 6, u.pm, u.pn); return true; }
    const int L2 = L - nq;
    if (L2 < 544) { pg8::grid_map(L2, 68, 8, u.pm, u.pn); u.pm += 68; u.pn += 6; return true; }
    return false;
  }
};

struct EpiG3 {
  static constexpr bool CHAIN = true;
  const Params& P;
  DI bool operator()(f32x4 (&acc)[2][2][4][2], const pg8::Unit& u, int wr, int wc, int fr, int fq) const {
    asm volatile("" : "+v"(fr), "+v"(fq));
    const int br = u.pm / 68, pm = u.pm - br * 68, pn = u.pn & 7;
    const int col = pn * 256 + 32 * wc + 8 * fq;
#pragma unroll
    for (int ai = 0; ai < 2; ai++) {
      const int tok0 = pm * 256 + ai * 128 + wr * 64 + fr;
      const u16* gp = P.sg() + (size_t)tok0 * 6144 + br * 2048 + col;
      u32x4 G[4][2], H[4][2];
#pragma unroll
      for (int m = 0; m < 4; m++)
#pragma unroll
        for (int bj = 0; bj < 2; bj++) {
          G[m][bj] = ld16(gp + (size_t)m * 16 * 6144 + bj * 128);
          H[m][bj] = (br < 2) ? ld16(gp + (size_t)m * 16 * 6144 + bj * 128 + 2048) : G[m][bj];
        }
      __builtin_amdgcn_sched_barrier(0);
#pragma unroll
      for (int m = 0; m < 4; m++)
#pragma unroll
        for (int bj = 0; bj < 2; bj++) {
          float g[8]; unpack8(G[m][bj], g);
#pragma unroll
          for (int j = 0; j < 8; j++) g[j] = __builtin_amdgcn_rcpf(g[j]);
          if (br < 2) {
            float g2[8]; unpack8(H[m][bj], g2);
#pragma unroll
            for (int j = 0; j < 8; j++) g[j] *= g2[j];
          }
          f32x4 a0 = acc[ai][bj][m][0], a1 = acc[ai][bj][m][1];
          a0.x *= g[0]; a0.y *= g[1]; a0.z *= g[2]; a0.w *= g[3]; a1.x *= g[4]; a1.y *= g[5]; a1.z *= g[6]; a1.w *= g[7];
          if (br < 2) { acc[ai][bj][m][0] = a0; acc[ai][bj][m][1] = a1; }
          else {
            u32x4 w; w.x = pack2(a0.x, a0.y); w.y = pack2(a0.z, a0.w); w.z = pack2(a1.x, a1.y); w.w = pack2(a1.z, a1.w);
            st16(P.m() + (size_t)(tok0 + m * 16) * DM + col + bj * 128, w);
          }
        }
    }
    return br < 2;
  }
};
struct OrderG3 {
  int G, c, MTu;
  DI bool next(int i, pg8::Unit& u) const {
    const int rt = i / 3, br = i - rt * 3;
    const int tI = rt * G + c;
    if (tI >= MTu * 8) return false;
    int pm, pn; pg8::grid_map(tI, MTu, 8, pm, pn);
    u.pm = br * 68 + pm; u.pn = br * 8 + pn; return true;
  }
};

struct EpiG4 {
  static constexpr bool CHAIN = false;
  const Params& P; int l;
  DI void operator()(const f32x4 (&acc)[2][2][4][2], const pg8::Unit& u, int wr, int wc, int fr, int fq) const {
    asm volatile("" : "+v"(fr), "+v"(fq));
    const bool lat = u.pm < 64;
    const int mrow = lat ? (u.pm >> 4) : 4;
    const int col = u.pn * 256 + 32 * wc + 8 * fq;
    const float* gp = P.mod() + (size_t)(l * 5 + mrow) * 6144 + 4096 + col;
    f32x4 gv[2][2];
#pragma unroll
    for (int bj = 0; bj < 2; bj++) { gv[bj][0] = *(const f32x4_a*)(gp + bj * 128); gv[bj][1] = *(const f32x4_a*)(gp + bj * 128 + 4); }
#pragma unroll
    for (int ai = 0; ai < 2; ai++) {
      const int tok0 = u.pm * 256 + ai * 128 + wr * 64 + fr;
      const float* xin = (l == 0) ? (lat ? P.x + (size_t)tok0 * DM : P.ctx + (size_t)(tok0 - NLAT) * DM)
                                  : (lat ? P.out + (size_t)tok0 * DM : P.xres() + (size_t)(tok0 - NLAT) * DM);
      float* xo = lat ? P.out + (size_t)tok0 * DM : P.xres() + (size_t)(tok0 - NLAT) * DM;
      f32x4 X[4][2][2];
#pragma unroll
      for (int m = 0; m < 4; m++)
#pragma unroll
        for (int bj = 0; bj < 2; bj++) {
          X[m][bj][0] = *(const f32x4_a*)(xin + (size_t)m * 16 * DM + col + bj * 128);
          X[m][bj][1] = *(const f32x4_a*)(xin + (size_t)m * 16 * DM + col + bj * 128 + 4);
        }
      __builtin_amdgcn_sched_barrier(0);
#pragma unroll
      for (int m = 0; m < 4; m++)
#pragma unroll
        for (int bj = 0; bj < 2; bj++) {
          *(f32x4_a*)(xo + (size_t)m * 16 * DM + col + bj * 128) = X[m][bj][0] + gv[bj][0] * acc[ai][bj][m][0];
          *(f32x4_a*)(xo + (size_t)m * 16 * DM + col + bj * 128 + 4) = X[m][bj][1] + gv[bj][1] * acc[ai][bj][m][1];
        }
    }
  }
};

DI int win_src(int n) {
  if (n < 1280) {
    int head = n >> 7, p = n & 127, blk = p >> 6, q = p & 63;
    return head * 128 + blk * 64 + (q & 1) * 32 + (q >> 1);
  }
  if (n < 3584) return n;
  if (n < 7680) return n + 64;
  if (n < 7744) { int p = n - 7680, blk = p >> 5, q = p & 31; return 3584 + blk * 32 + (q & 1) * 16 + (q >> 1); }
  if (n < 7936) return -1;
  return n - 192;
}
DI int uq_src(int n) {
  int head = n / 192, p = n - head * 192;
  if (p < 128) return n;
  int pp = p - 128, blk = pp >> 5, q = pp & 31;
  return head * 192 + 128 + blk * 32 + (q & 1) * 16 + (q >> 1);
}
template <int MAP>
DI void transpose_item(const float* __restrict__ src, int ld_src, int k0, int n0, const float* kscale,
                       u16* __restrict__ dst, int K, char* smem, int tid) {
  float* tl = (float*)smem;
  const int kk0 = tid >> 6;
  const bool vec = (MAP == 0) || (MAP == 1 && n0 >= 1280 && n0 != 7680);
  if (vec) {
    const int nq = tid & 63;
    int sc = n0 + nq * 4;
    if (MAP == 1) sc = win_src(sc);
    f32x4 v4[16];
#pragma unroll
    for (int i = 0; i < 16; i++) v4[i] = *(const f32x4_a*)(src + (size_t)(k0 + kk0 + 4 * i) * ld_src + sc);
    const int q = nq >> 4, nn = (nq & 15) * 4;
#pragma unroll
    for (int i = 0; i < 16; i++) {
      int kk = kk0 + 4 * i;
      float ksc = kscale ? kscale[k0 + kk] : 1.f;
      float* d = tl + (q * 64 + kk) * 65 + nn;
      d[0] = v4[i].x * ksc; d[1] = v4[i].y * ksc; d[2] = v4[i].z * ksc; d[3] = v4[i].w * ksc;
    }
  } else {
    const int nn = tid & 63;
    float v[4][16];
#pragma unroll
    for (int q = 0; q < 4; q++) {
      int sc = n0 + q * 64 + nn;
      if (MAP == 1) sc = win_src(sc);
      if (MAP == 2) sc = uq_src(sc);
#pragma unroll
      for (int i = 0; i < 16; i++) {
        int kk = kk0 + 4 * i;
        v[q][i] = (sc < 0) ? 0.f : src[(size_t)(k0 + kk) * ld_src + sc];
      }
    }
#pragma unroll
    for (int q = 0; q < 4; q++)
#pragma unroll
      for (int i = 0; i < 16; i++) {
        int kk = kk0 + 4 * i;
        float x = v[q][i];
        if (kscale) x *= kscale[k0 + kk];
        tl[(q * 64 + kk) * 65 + nn] = x;
      }
  }
  __syncthreads();
  const int n = tid >> 2, ks = (tid & 3) * 16;
#pragma unroll
  for (int q = 0; q < 4; q++) {
    const float* t = tl + (q * 64) * 65;
    u32x4 o0, o1;
    o0.x = pack2(t[(ks + 0) * 65 + n], t[(ks + 1) * 65 + n]);
    o0.y = pack2(t[(ks + 2) * 65 + n], t[(ks + 3) * 65 + n]);
    o0.z = pack2(t[(ks + 4) * 65 + n], t[(ks + 5) * 65 + n]);
    o0.w = pack2(t[(ks + 6) * 65 + n], t[(ks + 7) * 65 + n]);
    o1.x = pack2(t[(ks + 8) * 65 + n], t[(ks + 9) * 65 + n]);
    o1.y = pack2(t[(ks + 10) * 65 + n], t[(ks + 11) * 65 + n]);
    o1.z = pack2(t[(ks + 12) * 65 + n], t[(ks + 13) * 65 + n]);
    o1.w = pack2(t[(ks + 14) * 65 + n], t[(ks + 15) * 65 + n]);
    u16* d = dst + (size_t)(n0 + q * 64 + n) * K + k0 + ks;
    st16(d, o0); st16(d + 8, o1);
  }
  __syncthreads();
}

DI void ada_item(const Params& P, int it, char* smem) {
  const int tid = otid() & 255;
  const int l = it / 192, cc = it % 192;
  float* sc = (float*)smem;
  for (int i = tid; i < 5 * 2048; i += 256) {
    int r = i >> 11, k = i & 2047;
    float v = (r < 4) ? P.c[r * 2048 + k] : P.c_ctx[k];
    sc[i] = v / (1.f + expf(-v));
  }
  __syncthreads();
  const int cl = tid & 31, kg = tid >> 5;
  const float* wp = P.ada_w + (size_t)l * 2048 * 6144 + cc * 32 + cl;
  float a0 = 0.f, a1 = 0.f, a2 = 0.f, a3 = 0.f, a4 = 0.f;
#pragma unroll 8
  for (int k = kg * 256; k < kg * 256 + 256; k++) {
    float wv = wp[(size_t)k * 6144];
    a0 += wv * sc[k]; a1 += wv * sc[2048 + k]; a2 += wv * sc[4096 + k]; a3 += wv * sc[6144 + k]; a4 += wv * sc[8192 + k];
  }
  float* red = (float*)(smem + 40960);
  red[(kg * 5 + 0) * 32 + cl] = a0; red[(kg * 5 + 1) * 32 + cl] = a1; red[(kg * 5 + 2) * 32 + cl] = a2;
  red[(kg * 5 + 3) * 32 + cl] = a3; red[(kg * 5 + 4) * 32 + cl] = a4;
  __syncthreads();
  if (tid < 160) {
    int r = tid >> 5, c2 = tid & 31;
    float s = 0.f;
    for (int g = 0; g < 8; g++) s += red[(g * 5 + r) * 32 + c2];
    P.mod()[(size_t)(l * 5 + r) * 6144 + cc * 32 + c2] = s + P.ada_b[l * 6144 + cc * 32 + c2];
  }
  __syncthreads();
}


constexpr int W_ADA = 384, W_SGU = 128, W_TAB = 2;
constexpr int W_PRE = W_ADA + W_SGU + W_TAB;
constexpr int W_L_WIN = 55 * 32, W_L_UQ = 6 * 8, W_L_UKV = 8 * 8, W_L_WP = 3 * 8 * 16, W_L_WOUT = 8 * 32;
constexpr int W_L = W_L_WIN + W_L_UQ + W_L_UKV + W_L_WP + W_L_WOUT;

DI void phase_w(const Params& P, int l, int bid, int nb, char* smem0) {
  const int half = otid() >> 8, tid = otid() & 255;
  char* smem = smem0 + half * HALF_SMEM;
  const int pre = (l == 0) ? W_PRE : 0;
  const int total = pre + W_L;
  for (int it2 = bid; it2 * 2 < total; it2 += nb) {
    const int it = it2 * 2 + half;
    if (it < pre) {
      if (it < W_ADA) { ada_item(P, it, smem); continue; }
      int i = it - W_ADA;
      if (i < W_SGU) {
        size_t base = (size_t)i * 2048 + tid * 8;
        f32x4 a = *(const f32x4_a*)(P.sgu_w + base), b = *(const f32x4_a*)(P.sgu_w + base + 4);
        u32x4 o; o.x = pack2(a.x, a.y); o.y = pack2(a.z, a.w); o.z = pack2(b.x, b.y); o.w = pack2(b.z, b.w);
        st16(P.SguW() + base, o);
        continue;
      }
      i -= W_SGU;
      if (i == 0) {
        for (int e = tid; e < 64 * 32; e += 256) {
          int pos = e >> 5, fi = e & 31;
          float inv = powf(10000.f, -(float)fi / 32.f);
          float ang = (float)pos * inv;
          P.tab32()[e * 2] = cosf(ang); P.tab32()[e * 2 + 1] = sinf(ang);
        }
      } else {
        for (int e = tid; e < 64 * 16; e += 256) {
          int pos = e >> 4, fi = e & 15;
          float inv = powf(10000.f, -(float)fi / 16.f);
          float ang = (float)pos * inv;
          P.tab16()[e * 2] = cosf(ang); P.tab16()[e * 2 + 1] = sinf(ang);
        }
      }
      continue;
    }
    int i = it - pre;
    if (i < W_L_WIN) {
      int nbk = i >> 5, kb = i & 31;
      transpose_item<1>(P.w_in + (size_t)l * 2048 * 13888, 13888, kb * 64, nbk * 256, nullptr, P.WinT(), 2048, smem, tid);
      continue;
    }
    i -= W_L_WIN;
    if (i < W_L_UQ) {
      int nbk = i >> 3, kb = i & 7;
      transpose_item<2>(P.w_uq + (size_t)l * 512 * 1536, 1536, kb * 64, nbk * 256, P.mla_gq + l * 512, P.WuqT(), 512, smem, tid);
      continue;
    }
    i -= W_L_UQ;
    if (i < W_L_UKV) {
      int nbk = i >> 3, kb = i & 7;
      transpose_item<0>(P.w_ukv + (size_t)l * 512 * 2048, 2048, kb * 64, nbk * 256, P.mla_gkv + l * 512, P.WukvT(), 512, smem, tid);
      continue;
    }
    i -= W_L_UKV;
    if (i < W_L_WP) {
      int br = i / 128, j = i % 128;
      int nbk = j >> 4, kb = j & 15;
      const float* src = (br == 0 ? P.w_pa : (br == 1 ? P.w_pb : P.w_pc)) + (size_t)l * 1024 * 2048;
      transpose_item<0>(src, 2048, kb * 64, nbk * 256, nullptr, P.WpT() + (size_t)br * 2048 * 1024, 1024, smem, tid);
      continue;
    }
    i -= W_L_WP;
    {
      int nbk = i >> 5, kb = i & 31;
      transpose_item<0>(P.w_out + (size_t)l * 2048 * 2048, 2048, kb * 64, nbk * 256, nullptr, P.WoutT(), 2048, smem, tid);
    }
  }
}

DI void phase_norm(const Params& P, int l, int bid, int nb) {
  const int tid = otid(), lane = tid & 63, w = tid >> 6;
  for (int t = bid * 8 + w; t < T_TOK; t += nb * 8) {
    const float* src = (l == 0) ? (t < NLAT ? P.x + (size_t)t * DM : P.ctx + (size_t)(t - NLAT) * DM)
                                : (t < NLAT ? P.out + (size_t)t * DM : P.xres() + (size_t)(t - NLAT) * DM);
    const int mrow = t < NLAT ? (t >> 12) : 4;
    const float* md = P.mod() + (size_t)(l * 5 + mrow) * 6144;
    f32x4 v[8];
    float ss = 0.f;
#pragma unroll
    for (int i = 0; i < 8; i++) {
      v[i] = *(const f32x4_a*)(src + (lane + 64 * i) * 4);
      ss += v[i].x * v[i].x + v[i].y * v[i].y + v[i].z * v[i].z + v[i].w * v[i].w;
    }
#pragma unroll
    for (int o = 32; o >= 1; o >>= 1) ss += shx(ss, lane, o);
    const float rinv = rsqrtf(ss * (1.f / 2048.f) + EPS);
#pragma unroll
    for (int i = 0; i < 8; i++) {
      int c = (lane + 64 * i) * 4;
      f32x4 g = *(const f32x4_a*)(P.norm_g + l * 2048 + c);
      f32x4 sh = *(const f32x4_a*)(md + c);
      f32x4 sc = *(const f32x4_a*)(md + 2048 + c);
      float o0 = v[i].x * rinv * g.x * (1.f + sc.x) + sh.x;
      float o1 = v[i].y * rinv * g.y * (1.f + sc.y) + sh.y;
      float o2 = v[i].z * rinv * g.z * (1.f + sc.z) + sh.z;
      float o3 = v[i].w * rinv * g.w * (1.f + sc.w) + sh.w;
      u32x2 o; o.x = pack2(o0, o1); o.y = pack2(o2, o3);
      *(u32x2_a*)(P.h() + (size_t)t * DM + c) = o;
    }
  }
}

DI void phase_final(const Params& P, int bid, int nb) {
  const int tid = otid(), lane = tid & 63, w = tid >> 6;
  for (int t = bid * 8 + w; t < NLAT; t += nb * 8) {
    float* src = P.out + (size_t)t * DM;
    f32x4 v[8];
    float ss = 0.f;
#pragma unroll
    for (int i = 0; i < 8; i++) {
      v[i] = *(const f32x4_a*)(src + (lane + 64 * i) * 4);
      ss += v[i].x * v[i].x + v[i].y * v[i].y + v[i].z * v[i].z + v[i].w * v[i].w;
    }
#pragma unroll
    for (int o = 32; o >= 1; o >>= 1) ss += shx(ss, lane, o);
    const float rinv = rsqrtf(ss * (1.f / 2048.f) + EPS);
#pragma unroll
    for (int i = 0; i < 8; i++) {
      int c = (lane + 64 * i) * 4;
      f32x4 g = *(const f32x4_a*)(P.final_g + c);
      f32x4 o; o.x = v[i].x * rinv * g.x; o.y = v[i].y * rinv * g.y; o.z = v[i].z * rinv * g.z; o.w = v[i].w * rinv * g.w;
      *(f32x4_a*)(src + c) = o;
    }
  }
}

constexpr int VST = 144;
constexpr int SV_OFF = 25600;

struct AttnArgs {
  const u16* Q; int ldq;
  const u16* K1; int ldk1;
  const u16* K2;
  int seg0_row, seg0_n; const u16* seg0_vT; int seg0_ldv;
  int seg1_row, seg1_n; const u16* seg1_vT; int seg1_ldv;
  int qpos0, kpos0; bool mask0;
  bool has_sink; float sink_l2; float cscale;
  const u16* gate; u16* out;
};

constexpr int ATT_BUF = 45056;
template <int DQK>
DI void attn_item(const AttnArgs& a, char* smem) {
  constexpr int NS = DQK / 16;
  constexpr int KST = DQK * 2 + 16;
  const int tid = otid(), lane = tid & 63, w = tid >> 6, lr = lane & 31, hh = lane >> 5;

  bf16x8 qf[NS];
  {
    const u16* qp = a.Q + (size_t)(w * 32 + lr) * a.ldq + hh * 8;
#pragma unroll
    for (int s = 0; s < NS; s++) qf[s] = *(const bf16x8_a*)(qp + s * 16);
  }
  const int nt0 = a.seg0_n >> 6, ntot = nt0 + (a.seg1_n >> 6);
  u32x4 pk[3], pv[2];
  auto prefetch = [&](int tl) {
    int krow; const u16* vsrc; int ldv;
    if (tl < nt0) { krow = a.seg0_row + tl * 64; vsrc = a.seg0_vT + tl * 64; ldv = a.seg0_ldv; }
    else { int t2 = tl - nt0; krow = a.seg1_row + t2 * 64; vsrc = a.seg1_vT + t2 * 64; ldv = a.seg1_ldv; }
    const u16* p1 = a.K1 + (size_t)(krow + (tid >> 4)) * a.ldk1 + (tid & 15) * 8;
    pk[0] = ld16(p1); pk[1] = ld16(p1 + (size_t)32 * a.ldk1);
    if (DQK == 192) pk[2] = ld16(a.K2 + (size_t)(krow + (tid >> 3)) * 64 + (tid & 7) * 8);
    const u16* p3 = vsrc + (size_t)(tid >> 3) * ldv + (tid & 7) * 8;
    pv[0] = ld16(p3); pv[1] = ld16(p3 + (size_t)64 * ldv);
  };
  auto stash = [&](char* buf) {
    char* sK = buf; char* sV = buf + SV_OFF;
    st16(sK + (tid >> 4) * KST + (tid & 15) * 16, pk[0]);
    st16(sK + ((tid >> 4) + 32) * KST + (tid & 15) * 16, pk[1]);
    if (DQK == 192) st16(sK + (tid >> 3) * KST + 256 + (tid & 7) * 16, pk[2]);
    st16(sV + (tid >> 3) * VST + (tid & 7) * 16, pv[0]);
    st16(sV + ((tid >> 3) + 64) * VST + (tid & 7) * 16, pv[1]);
  };
  f32x16 O[4];
#pragma unroll
  for (int d = 0; d < 4; d++)
#pragma unroll
    for (int i = 0; i < 16; i++) O[d][i] = 0.f;
  float m = a.has_sink ? a.sink_l2 : -1e30f;
  float l = (a.has_sink && hh == 0) ? 1.f : 0.f;
  const int qp = a.qpos0 + w * 32 + lr;
  const int qlo = a.qpos0 + w * 32;

  prefetch(0);
  stash(smem);
  __syncthreads();
  if (ntot > 1) prefetch(1);
  for (int tl = 0; tl < ntot; tl++) {
    const char* sK = smem + (tl & 1) * ATT_BUF;
    const char* sV = sK + SV_OFF;
    const bool domask = a.mask0 && (tl < nt0);
    const int k0 = a.kpos0 + tl * 64;
    const bool skip = domask && ((k0 > qlo + 31 + 128) || (k0 + 63 < qlo - 128));
    if (!skip) {
      f32x16 S0, S1;
#pragma unroll
      for (int i = 0; i < 16; i++) { S0[i] = 0.f; S1[i] = 0.f; }
      {
        constexpr int NC = NS / 4;
        const char* kp0 = sK + lr * KST + hh * 16;
        const char* kp1 = kp0 + 32 * KST;
        bf16x8 ka[4], kb[4];
        __builtin_amdgcn_s_setprio(1);
#pragma unroll
        for (int s = 0; s < 4; s++) ka[s] = *(const bf16x8_a*)(kp0 + s * 32);
#pragma unroll
        for (int s = 0; s < 4; s++) kb[s] = *(const bf16x8_a*)(kp1 + s * 32);
        __builtin_amdgcn_sched_barrier(0);
#pragma unroll
        for (int c = 0; c < NC; c++) {
#pragma unroll
          for (int s = 0; s < 4; s++) {
            S0 = mfma32(ka[s], qf[c * 4 + s], S0);
            S1 = mfma32(kb[s], qf[c * 4 + s], S1);
            if (c + 1 < NC) {
              ka[s] = *(const bf16x8_a*)(kp0 + ((c + 1) * 4 + s) * 32);
              kb[s] = *(const bf16x8_a*)(kp1 + ((c + 1) * 4 + s) * 32);
            }
          }
          __builtin_amdgcn_sched_barrier(0);
        }
        __builtin_amdgcn_s_setprio(0);
      }
      if (domask) {
        const int kbase = k0 - qp;
#pragma unroll
        for (int i = 0; i < 16; i++) {
          int d0 = kbase + crow(i, hh), d1 = d0 + 32;
          if (d0 > 128 || d0 < -128) S0[i] = -1e30f;
          if (d1 > 128 || d1 < -128) S1[i] = -1e30f;
        }
      }
      const float m0 = fmaxf(S1[14], S1[15]);
      float mA = max3f(m0, S0[0], S0[1]), mB = max3f(m0, S1[0], S1[1]);
#pragma unroll
      for (int i = 1; i < 8; i++) mA = max3f(mA, S0[2 * i], S0[2 * i + 1]);
#pragma unroll
      for (int i = 1; i < 7; i++) mB = max3f(mB, S1[2 * i], S1[2 * i + 1]);
      float mx = max3f(mA, mB, mB);
      { const u32x2 hv = halves(mx); mx = max3f(__uint_as_float(hv.x), __uint_as_float(hv.y), __uint_as_float(hv.y)) * a.cscale; }
      if (__builtin_amdgcn_ballot_w64(mx > m + 8.f) != 0) {
        const float mnew = fmaxf(m, mx);
        const float alpha = __builtin_amdgcn_exp2f(m - mnew);
        m = mnew;
        l *= alpha;
#pragma unroll
        for (int d = 0; d < 4; d++)
#pragma unroll
          for (int i = 0; i < 16; i++) O[d][i] *= alpha;
      }
      float ls = 0.f;
#pragma unroll
      for (int i = 0; i < 16; i++) {
        float p0 = __builtin_amdgcn_exp2f(fmaf(S0[i], a.cscale, -m)), p1 = __builtin_amdgcn_exp2f(fmaf(S1[i], a.cscale, -m));
        S0[i] = p0; S1[i] = p1; ls += p0; ls += p1;
      }
      l += ls;
      u32x4 pp4[4];
#pragma unroll
      for (int sh = 0; sh < 2; sh++) {
        pp4[sh].x = pack2(S0[8 * sh + 0], S0[8 * sh + 1]); pp4[sh].y = pack2(S0[8 * sh + 2], S0[8 * sh + 3]);
        pp4[sh].z = pack2(S0[8 * sh + 4], S0[8 * sh + 5]); pp4[sh].w = pack2(S0[8 * sh + 6], S0[8 * sh + 7]);
        pp4[2 + sh].x = pack2(S1[8 * sh + 0], S1[8 * sh + 1]); pp4[2 + sh].y = pack2(S1[8 * sh + 2], S1[8 * sh + 3]);
        pp4[2 + sh].z = pack2(S1[8 * sh + 4], S1[8 * sh + 5]); pp4[2 + sh].w = pack2(S1[8 * sh + 6], S1[8 * sh + 7]);
      }
      __builtin_amdgcn_s_setprio(1);
      const char* vbase = sV + lr * VST + 8 * hh * 2;
      bf16x8 va[4], vb[4];
#pragma unroll
      for (int dt = 0; dt < 4; dt++) va[dt] = *(const bf16x8_a*)(vbase + dt * 32 * VST);
#pragma unroll
      for (int dt = 0; dt < 4; dt++) vb[dt] = *(const bf16x8_a*)(vbase + dt * 32 * VST + 32);
      __builtin_amdgcn_sched_barrier(0);
      {
        const bf16x8 pf = __builtin_bit_cast(bf16x8, pp4[0]);
#pragma unroll
        for (int dt = 0; dt < 4; dt++) { O[dt] = mfma32(va[dt], pf, O[dt]); va[dt] = *(const bf16x8_a*)(vbase + dt * 32 * VST + 64); }
      }
      __builtin_amdgcn_sched_barrier(0);
      {
        const bf16x8 pf = __builtin_bit_cast(bf16x8, pp4[1]);
#pragma unroll
        for (int dt = 0; dt < 4; dt++) { O[dt] = mfma32(vb[dt], pf, O[dt]); vb[dt] = *(const bf16x8_a*)(vbase + dt * 32 * VST + 96); }
      }
      __builtin_amdgcn_sched_barrier(0);
      {
        const bf16x8 pf = __builtin_bit_cast(bf16x8, pp4[2]);
#pragma unroll
        for (int dt = 0; dt < 4; dt++) O[dt] = mfma32(va[dt], pf, O[dt]);
      }
      {
        const bf16x8 pf = __builtin_bit_cast(bf16x8, pp4[3]);
#pragma unroll
        for (int dt = 0; dt < 4; dt++) O[dt] = mfma32(vb[dt], pf, O[dt]);
      }
      __builtin_amdgcn_s_setprio(0);
    }
    if (tl + 1 < ntot) stash(smem + ((tl + 1) & 1) * ATT_BUF);
    __syncthreads();
    if (tl + 2 < ntot) prefetch(tl + 2);
  }
  const u32x2 lh = halves(l);
  const float lt = __uint_as_float(lh.x) + __uint_as_float(lh.y);
  const float linv = 1.f / lt;
  {
    constexpr int OST = 272;
    char* ot = smem + w * (32 * OST);
#pragma unroll
    for (int dt = 0; dt < 4; dt++)
#pragma unroll
      for (int g4 = 0; g4 < 4; g4++) {
        const int d = dt * 32 + 8 * g4 + 4 * hh;
        u32x2 ov;
        ov.x = pack2(O[dt][4 * g4 + 0] * linv, O[dt][4 * g4 + 1] * linv);
        ov.y = pack2(O[dt][4 * g4 + 2] * linv, O[dt][4 * g4 + 3] * linv);
        *(u32x2_a*)(ot + lr * OST + d * 2) = ov;
      }
    __builtin_amdgcn_fence(__ATOMIC_RELEASE, "wavefront");
    asm volatile("s_waitcnt lgkmcnt(0)" ::: "memory");
#pragma unroll
    for (int i = 0; i < 8; i++) {
      const int id = lane + 64 * i, row = id >> 4, cc = id & 15;
      const size_t go = (size_t)(w * 32 + row) * 1024 + cc * 8;
      float ov[8], gv[8];
      unpack8(ld16(ot + row * OST + cc * 16), ov);
      unpack8(ld16(a.gate + go), gv);
#pragma unroll
      for (int j = 0; j < 8; j++) ov[j] *= gv[j];
      st16(a.out + go, pack8(ov));
    }
  }
  __syncthreads();
}

DI void attnA_any(const Params& P, int l, int it, char* smem) {
  const bool isl = it < 512;
  const int ia = isl ? it : it - 512;
  const int hq = ia & 7, kvh = hq >> 2;
  const int qsb = isl ? ((ia >> 3) & 15) : 0;
  const int b = isl ? (ia >> 7) : (ia >> 3);
  AttnArgs a;
  const size_t tq = isl ? ((size_t)b * 4096 + qsb * 256) : ((size_t)NLAT + b * 256);
  a.Q = P.q_a() + tq * 1024 + hq * 128; a.ldq = 1024;
  a.K1 = P.k_a() + kvh * 128; a.ldk1 = 256; a.K2 = P.k_a();
  int ks = qsb * 256 - 128; if (ks < 0) ks = 0;
  int ke = qsb * 256 + 384; if (ke > 4096) ke = 4096;
  const u16* vctx = P.vTa_ctx() + ((size_t)(b * 2 + kvh) * 128) * 256;
  if (isl) {
    a.seg0_row = b * 4096 + ks; a.seg0_n = ke - ks;
    a.seg0_vT = P.vTa_lat() + ((size_t)(b * 2 + kvh) * 128) * 4096 + ks; a.seg0_ldv = 4096;
    a.seg1_row = NLAT + b * 256; a.seg1_n = 256; a.seg1_vT = vctx; a.seg1_ldv = 256;
    a.qpos0 = qsb * 256; a.kpos0 = ks; a.mask0 = true;
  } else {
    a.seg0_row = NLAT + b * 256; a.seg0_n = 256; a.seg0_vT = vctx; a.seg0_ldv = 256;
    a.seg1_row = 0; a.seg1_n = 0; a.seg1_vT = vctx; a.seg1_ldv = 256;
    a.qpos0 = 0; a.kpos0 = 0; a.mask0 = false;
  }
  a.has_sink = true; a.sink_l2 = P.sink_a[l * 8 + hq] * LOG2E;
  a.cscale = 0.08838834764831845f * LOG2E;
  a.gate = P.saz() + tq * 1024 + hq * 128; a.out = P.ya() + tq * 1024 + hq * 128;
  attn_item<128>(a, smem);
}
DI void attnB_any(const Params& P, int it, char* smem, bool dummy = false) {
  const bool isl = it < 512;
  const int ia = isl ? it : it - 512;
  const int hq = ia & 7;
  const int qsb = isl ? ((ia >> 3) & 15) : 0;
  const int b = isl ? (ia >> 7) : (ia >> 3);
  AttnArgs a;
  const size_t tq = isl ? ((size_t)b * 4096 + qsb * 256) : ((size_t)NLAT + b * 256);
  a.Q = P.q_b() + tq * 1536 + hq * 192; a.ldq = 1536;
  a.K1 = P.kn_b() + hq * 128; a.ldk1 = 1024; a.K2 = P.kr();
  const u16* vctx = P.vTb_ctx() + ((size_t)(b * 8 + hq) * 128) * 256;
  if (isl) {
    a.seg0_row = b * 4096; a.seg0_n = 4096;
    a.seg0_vT = P.vTb_lat() + ((size_t)(b * 8 + hq) * 128) * 4096; a.seg0_ldv = 4096;
    a.seg1_row = NLAT + b * 256; a.seg1_n = 256; a.seg1_vT = vctx; a.seg1_ldv = 256;
  } else {
    a.seg0_row = NLAT + b * 256; a.seg0_n = 256; a.seg0_vT = vctx; a.seg0_ldv = 256;
    a.seg1_row = 0; a.seg1_n = 0; a.seg1_vT = vctx; a.seg1_ldv = 256;
  }
  a.qpos0 = 0; a.kpos0 = 0; a.mask0 = false;
  a.has_sink = false; a.sink_l2 = 0.f;
  a.cscale = 0.07216878364870322f * LOG2E;
  a.gate = P.sbz() + tq * 1024 + hq * 128; a.out = (dummy ? P.h() : P.yb()) + tq * 1024 + hq * 128;
  attn_item<192>(a, smem);
}

constexpr int SGU_ST = 272;
DI void sgu_item(const Params& P, int l, int ch, int g, char* smem) {
  const int tid = otid() & 255, lane = tid & 63, w = tid >> 6, wr = w >> 1, wc = w & 1, lr = lane & 31, hh = lane >> 5;
  float* st = (float*)(smem + 2 * 128 * SGU_ST);
  if (tid < 128) {
    const float* sp = P.cvst() + (size_t)(ch * 128 + tid) * 32;
    float s1 = 0.f, s2 = 0.f;
#pragma unroll
    for (int j = 0; j < 16; j++) { s1 += sp[2 * j]; s2 += sp[2 * j + 1]; }
    float mu = s1 * (1.f / 1024.f);
    float var = s2 * (1.f / 1024.f) - mu * mu;
    st[tid * 2] = mu; st[tid * 2 + 1] = rsqrtf(fmaxf(var, 0.f) + EPS);
  }
  __syncthreads();
  char* sA = smem; char* sB = smem + 128 * SGU_ST;
  const u16* Ag = P.SguW() + (size_t)(l * 8 + g) * 128 * 128;
  const u16* Bg = P.cvT() + ((size_t)ch * 1024 + g * 128) * 128;
#pragma unroll
  for (int i = 0; i < 8; i++) {
    int id = tid + 256 * i, r = id >> 4, cc = id & 15;
    st16(sA + r * SGU_ST + cc * 16, ld16(Ag + r * 128 + cc * 8));
    float v[8]; unpack8(ld16(Bg + r * 128 + cc * 8), v);
    float gam = P.sgu_ln_g[l * 1024 + g * 128 + r], bet = P.sgu_ln_b[l * 1024 + g * 128 + r];
#pragma unroll
    for (int e = 0; e < 8; e++) {
      int q = cc * 8 + e;
      v[e] = (v[e] - st[2 * q]) * st[2 * q + 1] * gam + bet;
    }
    st16(sB + r * SGU_ST + cc * 16, pack8(v));
  }
  __syncthreads();
  f32x16 acc[2][2]; zero_acc(acc);
  {
    const char* pa = sA + (wr * 64 + lr) * SGU_ST + hh * 16;
    const char* pb = sB + (wc * 64 + lr) * SGU_ST + hh * 16;
#pragma unroll
    for (int s = 0; s < 8; s++) {
      bf16x8 a0 = *(const bf16x8_a*)(pa + s * 32);
      bf16x8 a1 = *(const bf16x8_a*)(pa + 32 * SGU_ST + s * 32);
      bf16x8 b0 = *(const bf16x8_a*)(pb + s * 32);
      bf16x8 b1 = *(const bf16x8_a*)(pb + 32 * SGU_ST + s * 32);
      acc[0][0] = mfma32(a0, b0, acc[0][0]);
      acc[0][1] = mfma32(a0, b1, acc[0][1]);
      acc[1][0] = mfma32(a1, b0, acc[1][0]);
      acc[1][1] = mfma32(a1, b1, acc[1][1]);
    }
  }
  __syncthreads();
  float* stg = (float*)smem;
  stage_acc(acc, stg, tid);
  __syncthreads();
#pragma unroll
  for (int j = 0; j < 8; j++) {
    int id = tid + 256 * j, r = id >> 4, c8 = (id & 15) * 8;
    float v[8]; ldstg8(stg, r, c8, v);
    const size_t off = (size_t)(ch * 128 + r) * 1024 + g * 128 + c8;
    float u[8], z[8];
    unpack8(ld16(P.cu() + off), u); unpack8(ld16(P.scz() + off), z);
    float bs = P.sgu_b[(l * 8 + g) * 128 + r];
#pragma unroll
    for (int e = 0; e < 8; e++) v[e] = u[e] * (v[e] + bs) * z[e];
    st16(P.yc() + off, pack8(v));
  }
  __syncthreads();
}


DI void phase_g1(const Params& P, int l, int bid, int nb, char* smem) {
  OrderG1 S{nb, bid, l};
  EpiG1 E{P};
  pg8::gemm_phase(( PG8_LAS unsigned char*)smem, P.h(), P.WinT(), 2048, S, E);
}
DI void phase_g2(const Params& P, int l, int bid, int nb, char* smem) {
  const int half = otid() >> 8;
  char* hs = smem + half * HALF_SMEM;
  const int na = (l == 0) ? 544 : 512;
  for (int it = bid; it < na; it += nb) attnA_any(P, l, it, smem);
  {
    OrderG2 S{nb, bid, l};
    EpiG2 E{P};
    pg8::gemm_phase((PG8_LAS unsigned char*)smem, P.cq(), P.WuqT(), 512, S, E);
  }
  const int nch = (l == 0) ? 136 : 128;
  for (int it2 = bid; it2 * 2 < nch * 8; it2 += nb) { const int it = it2 * 2 + half; sgu_item(P, l, it >> 3, it & 7, hs); }
}
DI void phase_attb(const Params& P, int l, int bid, int nb, char* smem) {
  const int half = otid() >> 8;
  char* hs = smem + half * HALF_SMEM;
  const int na = (l == 0) ? 544 : 512;
#if MK_DUP & 2
  for (int it = bid; it < na; it += nb) attnB_any(P, it, smem, true);
#endif
  for (int it = bid; it < na; it += nb) attnB_any(P, it, smem);
}
DI void phase_g3(const Params& P, int l, int bid, int nb, char* smem) {
  OrderG3 S{nb, bid, (l == 0) ? 68 : 64};
  EpiG3 E{P};
  pg8::gemm_phase((PG8_LAS unsigned char*)smem, P.ya(), P.WpT(), 1024, S, E);
}
DI void phase_g4(const Params& P, int l, int bid, int nb, char* smem) {
  pg8::GridOrder S; S.init((l == 0) ? 68 : 64, 8, nb, bid);
  EpiG4 E{P, l};
  pg8::gemm_phase((PG8_LAS unsigned char*)smem, P.m(), P.WoutT(), 2048, S, E);
}

DI void run_phase(const Params& P, int ph, int bid, int nb, char* smem) {
  if (ph == 0) { phase_w(P, 0, bid, nb, smem); return; }
  if (ph == 13) { phase_final(P, bid, nb); return; }
  const int l = (ph - 1) / 6, s = (ph - 1) % 6;
  switch (s) {
    case 0: phase_norm(P, l, bid, nb); if (l == 1) phase_w(P, 1, bid, nb, smem); break;
    case 1: phase_g1(P, l, bid, nb, smem); break;
    case 2: phase_g2(P, l, bid, nb, smem); break;
    case 3: phase_attb(P, l, bid, nb, smem); break;
    case 4: phase_g3(P, l, bid, nb, smem); break;
    default: phase_g4(P, l, bid, nb, smem); break;
  }
}

extern __shared__ __attribute__((aligned(16))) char dyn_smem[];

DI void fast_grid_sync(unsigned* bar, unsigned k, unsigned nb) {
  asm volatile("s_waitcnt vmcnt(0)" ::: "memory");
  __syncthreads();
  if (threadIdx.x == 0) {
    __builtin_amdgcn_fence(__ATOMIC_RELEASE, "agent");
    asm volatile("s_waitcnt vmcnt(0)" ::: "memory");
    const unsigned g = blockIdx.x >> 4;
    const unsigned ngroups = (nb + 15u) >> 4;
    const unsigned gsz = (g + 1u == ngroups) ? nb - g * 16u : 16u;
    unsigned* rel = bar + 32 * 17;
    const unsigned old = __hip_atomic_fetch_add(bar + 32 * g, 1u, __ATOMIC_RELAXED, __HIP_MEMORY_SCOPE_AGENT);
    if (old + 1u == k * gsz) {
      const unsigned t = __hip_atomic_fetch_add(bar + 32 * 16, 1u, __ATOMIC_RELAXED, __HIP_MEMORY_SCOPE_AGENT);
      if (t + 1u == k * ngroups) __hip_atomic_store(rel, k, __ATOMIC_RELAXED, __HIP_MEMORY_SCOPE_AGENT);
    }
    while (__hip_atomic_load(rel, __ATOMIC_RELAXED, __HIP_MEMORY_SCOPE_AGENT) < k) __builtin_amdgcn_s_sleep(1);
    __builtin_amdgcn_fence(__ATOMIC_ACQUIRE, "agent");
    asm volatile("s_waitcnt vmcnt(0)" ::: "memory");
  }
  __syncthreads();
}

#if MK_MULTI
__global__ void __launch_bounds__(NTHR, 2) k_phase(Params P, int ph) {
  run_phase(P, ph, blockIdx.x, gridDim.x, dyn_smem);
}
#endif

#if !MK_MULTI
__global__ void __launch_bounds__(NTHR, 2) k_mega(Params P) {
  const int bid = blockIdx.x, nb = gridDim.x;
  unsigned* ctr = (unsigned*)(P.ws + WS_BAR);
  unsigned nsync = 0;
#define GSYNC() do { nsync += 1u; fast_grid_sync(ctr, nsync, (unsigned)nb); } while (0)
  phase_w(P, 0, bid, nb, dyn_smem);
  if (nb < 0) cg::this_grid().sync();
  GSYNC();
#pragma unroll 1
  for (int l = 0; l < 2; l++) {
    phase_norm(P, l, bid, nb);
    if (l == 1) phase_w(P, 1, bid, nb, dyn_smem);
    GSYNC();
#if MK_DUP & 1
    phase_g1(P, l, bid, nb, dyn_smem); GSYNC();
#endif
    phase_g1(P, l, bid, nb, dyn_smem); GSYNC();
    phase_g2(P, l, bid, nb, dyn_smem); GSYNC();
    phase_attb(P, l, bid, nb, dyn_smem); GSYNC();
#if MK_DUP & 4
    phase_g3(P, l, bid, nb, dyn_smem); GSYNC();
#endif
    phase_g3(P, l, bid, nb, dyn_smem); GSYNC();
    phase_g4(P, l, bid, nb, dyn_smem); GSYNC();
  }
  phase_final(P, bid, nb);
#undef GSYNC
}
#endif

__global__ void k_fill(float* o, int n, float v) { int i = blockIdx.x * 256 + threadIdx.x; if (i < n) o[i] = v; }

extern "C" void kernel_launch(void* const* d_in, const int* in_sizes, int n_in, void* d_out, int out_size, void* d_ws,
                              size_t ws_size, hipStream_t stream) {
  static int grid_blocks = 0;
  if (!grid_blocks) {
    int dev = 0, cus = 0, per_cu = 0;
    hipGetDevice(&dev);
    hipDeviceGetAttribute(&cus, hipDeviceAttributeMultiprocessorCount, dev);
#if MK_MULTI
    const void* kfn = (const void*)k_phase;
#else
    const void* kfn = (const void*)k_mega;
#endif
    hipFuncSetAttribute(kfn, hipFuncAttributeMaxDynamicSharedMemorySize, SMEM_BYTES);
    hipOccupancyMaxActiveBlocksPerMultiprocessor(&per_cu, kfn, NTHR, SMEM_BYTES);
    if (per_cu < 1) per_cu = 1;
    grid_blocks = cus;
    (void)hipGetLastError();
  }
  Params P{};
  const float** ins = (const float**)&P;
  for (int i = 0; i < 22; i++) ins[i] = (const float*)d_in[i];
  P.out = (float*)d_out;
  P.ws = (char*)d_ws;
  if (WS_TOTAL > ws_size || grid_blocks > 256) {
    fprintf(stderr, "workspace too small or unexpected grid\n");
    hipLaunchKernelGGL(k_fill, dim3((out_size + 255) / 256), dim3(256), 0, stream, (float*)d_out, out_size, 7777.f);
    return;
  }
#if MK_MULTI
  for (int ph = 0; ph < 14; ph++) hipLaunchKernelGGL(k_phase, dim3(grid_blocks), dim3(NTHR), SMEM_BYTES, stream, P, ph);
#else
  hipMemsetAsync((char*)d_ws + WS_BAR, 0, 4096, stream);
  void* args[] = {&P};
  hipError_t e = hipLaunchCooperativeKernel((const void*)k_mega, dim3(grid_blocks), dim3(NTHR), args, SMEM_BYTES, stream);
  if (e != hipSuccess) fprintf(stderr, "cooperative launch failed: %s (grid %d)\n", hipGetErrorString(e), grid_blocks);
#endif
}
```
